# Optimizing an MI355X kernel written in HIP

```python
import jax, jax.numpy as jnp
from jax import lax
import numpy as np

D_MODEL = 2048
BATCH = 8
SEQ = 2048
DEPTH = 1

D_MIX = D_MODEL
A_HEADS = 8
A_HEAD_DIM = 128
A_WIDTH = A_HEADS * A_HEAD_DIM
DILATED_PATTERNS = ((128, 1), (512, 4), (2048, 16))
B_HEADS = 8
B_V_DIM = 128
B_WIDTH = B_HEADS * B_V_DIM
B_NOPE_DIM = 128
B_ROPE_DIM = 64
Q_LORA_RANK = 512
KV_LORA_RANK = 256
ROPE_THETA = 10000.0
NORM_EPS = 1e-6
Q_BLOCK = 128
NEG_INF = -1e30
IN_SIZES = (A_WIDTH, A_WIDTH, A_WIDTH, A_WIDTH, Q_LORA_RANK, KV_LORA_RANK, B_ROPE_DIM, B_WIDTH)
D_IN = A_WIDTH * 4 + Q_LORA_RANK + KV_LORA_RANK + B_ROPE_DIM + B_WIDTH

kernel_name = 'hymba_dilated_mla_adaln_block'


def rms_norm(x, g):
    xf = x.astype(jnp.float32)
    y = xf * lax.rsqrt(jnp.mean(xf * xf, axis=-1, keepdims=True) + NORM_EPS)
    return (y * g.astype(jnp.float32)).astype(x.dtype)


def alibi_slopes(n_heads):
    return jnp.exp2(-8.0 * jnp.arange(1, n_heads + 1, dtype=jnp.float32) / n_heads)


def banded_attention(q, k, v, radius, dist_slope):
    *lead, L, hd = q.shape
    nlead = len(lead)
    blk = radius
    nb = -(-L // blk)
    lp = nb * blk
    qb = jnp.pad(q, [(0, 0)] * nlead + [(0, lp - L), (0, 0)]).reshape(*lead, nb, blk, hd)

    def windows(a):
        ap = jnp.pad(a, [(0, 0)] * nlead + [(blk, lp - L + blk), (0, 0)]).reshape(*lead, nb + 2, blk, hd)
        return jnp.concatenate([ap[..., :-2, :, :], ap[..., 1:-1, :, :], ap[..., 2:, :, :]], axis=-2)

    kw, vw = windows(k), windows(v)
    s = jnp.einsum('...nqd,...nkd->...nqk', qb, kw).astype(jnp.float32) * (hd ** -0.5)
    qpos = jnp.arange(lp).reshape(nb, blk)
    kpos = qpos[:, :1] - blk + jnp.arange(3 * blk)[None, :]
    rel = kpos[:, None, :] - qpos[:, :, None]
    valid = (jnp.abs(rel) <= radius) & (kpos >= 0)[:, None, :] & (kpos < L)[:, None, :]
    s = jnp.where(valid, s - dist_slope * jnp.abs(rel).astype(jnp.float32), NEG_INF)
    m = jnp.max(s, axis=-1, keepdims=True)
    p = jnp.exp(s - m)
    l = jnp.sum(p, axis=-1, keepdims=True)
    o = jnp.einsum('...nqk,...nkd->...nqd', p, vw.astype(jnp.float32)) / l
    lse = (m + jnp.log(l))[..., 0]
    o = o.reshape(*lead, lp, hd)[..., :L, :]
    lse = lse.reshape(*lead, lp)[..., :L]
    return o, lse


def dilated_mixture(q, k, v):
    B, T, H, hd = q.shape
    slopes = alibi_slopes(H)
    outs, lses = [], []
    for window, dil in DILATED_PATTERNS:
        radius = window // 2 // dil
        L = T // dil

        def to_strided(a):
            return a.reshape(B, L, dil, H, hd).transpose(0, 2, 3, 1, 4)

        o, lse = banded_attention(to_strided(q), to_strided(k), to_strided(v), radius,
                                  (slopes * dil)[:, None, None, None])
        outs.append(o.transpose(0, 3, 1, 2, 4).reshape(B, T, H, hd))
        lses.append(lse.transpose(0, 3, 1, 2).reshape(B, T, H))
    w = jax.nn.softmax(jnp.stack(lses, axis=0), axis=0)
    out = jnp.einsum('pbth,pbthd->bthd', w, jnp.stack(outs, axis=0))
    return out.astype(q.dtype)


def apply_rope(x, cos, sin):
    x1, x2 = jnp.split(x, 2, axis=-1)
    return jnp.concatenate([x1 * cos - x2 * sin, x1 * sin + x2 * cos], axis=-1)


def dense_attention(q, k, v):
    B, T, H, dk = q.shape
    nq = T // Q_BLOCK
    qb = q.reshape(B, nq, Q_BLOCK, H, dk).transpose(1, 0, 2, 3, 4)
    scale = dk ** -0.5

    def one_block(qi):
        s = jnp.einsum('bqhd,bkhd->bhqk', qi, k).astype(jnp.float32) * scale
        p = jax.nn.softmax(s, axis=-1)
        return jnp.einsum('bhqk,bkhd->bqhd', p.astype(v.dtype), v)

    o = lax.map(one_block, qb)
    return o.transpose(1, 0, 2, 3, 4).reshape(B, T, H, v.shape[-1])


def mla(cq, ckv, kpe, g_q_lora, w_uq, g_kv_lora, w_ukv):
    B, T, _ = cq.shape
    q = (rms_norm(cq, g_q_lora) @ w_uq).reshape(B, T, B_HEADS, B_NOPE_DIM + B_ROPE_DIM)
    q_nope, q_pe = q[..., :B_NOPE_DIM], q[..., B_NOPE_DIM:]
    kv = (rms_norm(ckv, g_kv_lora) @ w_ukv).reshape(B, T, B_HEADS, B_NOPE_DIM + B_V_DIM)
    k_nope, v = kv[..., :B_NOPE_DIM], kv[..., B_NOPE_DIM:]
    half = B_ROPE_DIM // 2
    pos = jnp.arange(T, dtype=jnp.float32)
    inv_freq = jnp.power(ROPE_THETA, -jnp.arange(half, dtype=jnp.float32) / half)
    ang = pos[:, None] * inv_freq[None, :]
    cos, sin = jnp.cos(ang).astype(cq.dtype), jnp.sin(ang).astype(cq.dtype)
    q_pe = apply_rope(q_pe, cos[None, :, None, :], sin[None, :, None, :])
    k_pe = apply_rope(kpe, cos[None], sin[None])
    k_pe = jnp.broadcast_to(k_pe[:, :, None, :], (B, T, B_HEADS, B_ROPE_DIM))
    q_full = jnp.concatenate([q_nope, q_pe], axis=-1)
    k_full = jnp.concatenate([k_nope, k_pe], axis=-1)
    return dense_attention(q_full, k_full, v)


def hybrid_layer(x, c, w_ada, b_ada, g_pre, w_in, g_q_lora, w_uq, g_kv_lora, w_ukv, w_out, g_post):
    B, T, _ = x.shape
    mod = jax.nn.silu(c) @ w_ada + b_ada
    shift, scale, gate = jnp.split(mod, 3, axis=-1)
    h = rms_norm(x, g_pre) * (1.0 + scale[:, None, :]) + shift[:, None, :]
    proj = h @ w_in
    split_points = [int(s) for s in np.cumsum(IN_SIZES)[:-1]]
    a_q, a_k, a_v, a_z, b_cq, b_ckv, b_kpe, b_z = jnp.split(proj, split_points, axis=-1)
    head_shape = (B, T, A_HEADS, A_HEAD_DIM)
    y_a = dilated_mixture(a_q.reshape(head_shape), a_k.reshape(head_shape), a_v.reshape(head_shape))
    y_a = y_a.reshape(B, T, A_WIDTH) * jax.nn.silu(a_z)
    y_b = mla(b_cq, b_ckv, b_kpe, g_q_lora, w_uq, g_kv_lora, w_ukv).reshape(B, T, B_WIDTH) * jax.nn.silu(b_z)
    y = jnp.concatenate([y_a, y_b], axis=-1) @ w_out
    return x + gate[:, None, :] * rms_norm(y, g_post)


def setup_inputs(seed: int = 0) -> dict:
    key = jax.random.key(seed)
    ks = jax.random.split(key, 14)
    f32 = jnp.float32

    def nrm(k, shape, s):
        return jax.random.normal(k, shape, f32) * s

    return {
        'x': nrm(ks[0], (BATCH, SEQ, D_MODEL), 1.0),
        'c': nrm(ks[1], (BATCH, D_MODEL), 1.0),
        'w_ada': nrm(ks[2], (DEPTH, D_MODEL, 3 * D_MODEL), 0.5 * D_MODEL ** -0.5),
        'b_ada': nrm(ks[3], (DEPTH, 3 * D_MODEL), 0.01),
        'g_pre': 1.0 + nrm(ks[4], (DEPTH, D_MODEL), 0.01),
        'w_in': nrm(ks[5], (DEPTH, D_MODEL, D_IN), D_MODEL ** -0.5),
        'g_q_lora': 1.0 + nrm(ks[6], (DEPTH, Q_LORA_RANK), 0.01),
        'w_uq': nrm(ks[7], (DEPTH, Q_LORA_RANK, B_HEADS * (B_NOPE_DIM + B_ROPE_DIM)), Q_LORA_RANK ** -0.5),
        'g_kv_lora': 1.0 + nrm(ks[8], (DEPTH, KV_LORA_RANK), 0.01),
        'w_ukv': nrm(ks[9], (DEPTH, KV_LORA_RANK, B_HEADS * (B_NOPE_DIM + B_V_DIM)), KV_LORA_RANK ** -0.5),
        'w_out': nrm(ks[10], (DEPTH, D_MIX, D_MODEL), D_MIX ** -0.5),
        'g_post': 1.0 + nrm(ks[11], (DEPTH, D_MODEL), 0.01),
    }


def reference(x, c, w_ada, b_ada, g_pre, w_in, g_q_lora, w_uq, g_kv_lora, w_ukv, w_out, g_post):
    for layer in range(DEPTH):
        x = hybrid_layer(x, c, w_ada[layer], b_ada[layer], g_pre[layer], w_in[layer],
                         g_q_lora[layer], w_uq[layer], g_kv_lora[layer], w_ukv[layer],
                         w_out[layer], g_post[layer])
    return x
```

```cpp
#include <hip/hip_runtime.h>
#include <cstdio>
#include <cstdint>
namespace pg8 {
#define PG8_LAS __attribute__((address_space(3)))
typedef unsigned short bf16_t;
typedef short bf16x8 __attribute__((ext_vector_type(8)));
typedef float f32x4 __attribute__((ext_vector_type(4)));
typedef unsigned u32x4 __attribute__((ext_vector_type(4)));
constexpr int BM = 256, BK = 64, HALF = 128, HTB = HALF * BK * 2  , STAGE_BYTES = 8 * HTB, NXCD = 8, WGM = 8;

__host__ __device__ __forceinline__ int lds_byte(int r, int c) { const int st = (r >> 4) * 2 + (c >> 5), rr = r & 15, cc = c & 31, ob = rr * 64 + cc * 2; return st * 1024 + (ob ^ (((ob >> 9) & 1) << 5)); }
__host__ __device__ __forceinline__ void stage_rc(int b, int& R, int& C) { const int st = b / 1024, sb = b % 1024, swz = sb ^ (((sb >> 9) & 1) << 5); R = (st >> 1) * 16 + swz / 64; C = (st & 1) * 32 + (swz % 64) / 2; }
__host__ __device__ __forceinline__ int perm32(int rho) { const int n = rho >> 4, i = rho & 15; return 8 * (i >> 2) + 4 * n + (i & 3); }

struct Unit { int pm, pn; };
struct Gemm { const bf16_t* A; const bf16_t* Bt; int M, N, K; };

struct StaticOrder {
    int nM, nN, nwg, G, c;
    __host__ __device__ void init(int M, int N, int G_, int c_) { nM = M / BM; nN = N / BM; nwg = nM * nN; G = G_; c = c_; }
    __host__ __device__ bool next(int i, Unit& u) const {
        const long L = (long)i * G + c; if (L >= nwg) return false;
        int wgid = (int)L; { const int q = nwg / NXCD, r = nwg % NXCD, xcd = wgid % NXCD, off = wgid / NXCD; wgid = (xcd < r ? xcd * (q + 1) : r * (q + 1) + (xcd - r) * q) + off; }
        const int nig = WGM * nN, gid = wgid / nig, fm = gid * WGM, gsz = (nM - fm) < WGM ? (nM - fm) : WGM;
        u.pm = fm + ((wgid % nig) % gsz); u.pn = (wgid % nig) / gsz; return true;
    }
    __device__ __forceinline__ void a_ready(const Unit&) const {}
    __device__ __forceinline__ void done(const Unit&) const {}
};

__device__ __forceinline__ unsigned cvt_pk_bf16(float lo, float hi) { unsigned r; asm volatile("v_cvt_pk_bf16_f32 %0, %1, %2" : "=v"(r) : "v"(lo), "v"(hi)); return r; }
typedef float f32x2 __attribute__((ext_vector_type(2)));
__device__ __forceinline__ f32x2 gelu_pk(f32x2 v) {
    const f32x2 av = __builtin_elementwise_abs(v), d = av * 0.2316418882f + 1.0f;
    f32x2 t; t.x = __builtin_amdgcn_rcpf(d.x); t.y = __builtin_amdgcn_rcpf(d.y);
    f32x2 q = t * 0.5307027145f + (-0.7265760135f); q = q * t + 0.7107068705f; q = q * t + (-0.142248368f); q = q * t + 0.127414796f; q = q * t;
    const f32x2 s = (v * v) * (-0.72134752044f);
    f32x2 e; e.x = __builtin_amdgcn_exp2f(s.x); e.y = __builtin_amdgcn_exp2f(s.y);
    const f32x2 m = v * (q * e), r = v - m;
    f32x2 o; o.x = v.x < 0.f ? m.x : r.x; o.y = v.y < 0.f ? m.y : r.y; return o;
}

template <int ACT  > struct EpiBf16 {
    static constexpr bool PERM = true, AFTER_DRAIN = false; static_assert(ACT == 0 || ACT == 1, "EpiBf16: ACT is 0 (none) or 1 (gelu_pk)");
    bf16_t* O; int ldc; const float* bias; int split_cols; size_t split_stride; float scale0;
    __device__ __forceinline__ void operator()(const f32x4 (&acc)[2][2][4][2], const Unit& u, int wr, int wc, int fr, int fq) const {
        const int row0 = u.pm * BM + wr * 64 + fr; int colt = u.pn * BM; bf16_t* base = O;
        float sc = 1.f; if (split_cols) { const int t = colt / split_cols; base += (size_t)t * split_stride; colt -= t * split_cols; if (t == 0) sc = scale0; }
        const int col0 = colt + wc * 32 + 8 * fq, bcol0 = u.pn * BM + wc * 32 + 8 * fq;
        f32x4 bv[2][2];
#pragma unroll
        for (int bj = 0; bj < 2; ++bj)
#pragma unroll
            for (int n = 0; n < 2; ++n) bv[bj][n] = bias ? *(const f32x4*)(bias + bcol0 + bj * HALF + 4 * n) : (f32x4){0.f, 0.f, 0.f, 0.f};
#pragma unroll
        for (int ai = 0; ai < 2; ++ai)
#pragma unroll
            for (int m = 0; m < 4; ++m) { bf16_t* rowp = base + (size_t)(row0 + ai * HALF + m * 16) * ldc + col0;
#pragma unroll
                for (int bj = 0; bj < 2; ++bj) { f32x4 v0 = acc[ai][bj][m][0] + bv[bj][0], v1 = acc[ai][bj][m][1] + bv[bj][1];
                    if (ACT == 1) { f32x2 a = gelu_pk((f32x2){v0[0], v0[1]}), b = gelu_pk((f32x2){v0[2], v0[3]}), c = gelu_pk((f32x2){v1[0], v1[1]}), d = gelu_pk((f32x2){v1[2], v1[3]});
                        v0 = (f32x4){a.x, a.y, b.x, b.y}; v1 = (f32x4){c.x, c.y, d.x, d.y}; }
                    v0 = v0 * sc; v1 = v1 * sc; u32x4 w; w.x = cvt_pk_bf16(v0[0], v0[1]); w.y = cvt_pk_bf16(v0[2], v0[3]); w.z = cvt_pk_bf16(v1[0], v1[1]); w.w = cvt_pk_bf16(v1[2], v1[3]);
                    *(u32x4*)(rowp + bj * HALF) = w; } }
    }
};

struct PanelStats {
    unsigned* xbuf;
    unsigned* cnt;
    unsigned* tmo;
    int ntn; float eps;
    unsigned code;
    __device__ __forceinline__ bool run(const f32x4 (&v)[2][2][4][2], const Unit& u, int wr, int wc, int fr, int fq, PG8_LAS unsigned char* lds, int wid, int lane) const {
        typedef float f32x2v __attribute__((ext_vector_type(2)));
        PG8_LAS f32x2v* P = (PG8_LAS f32x2v*)lds;
        PG8_LAS f32x2v* S = (PG8_LAS f32x2v*)(lds + 8192);
        PG8_LAS unsigned* flag = (PG8_LAS unsigned*)(lds + 8192 + 2048);
#pragma unroll
        for (int ai = 0; ai < 2; ++ai)
#pragma unroll
            for (int m = 0; m < 4; ++m) {
                float s = 0.f;
#pragma unroll
                for (int bj = 0; bj < 2; ++bj)
#pragma unroll
                    for (int n = 0; n < 2; ++n) { const f32x4 x = v[ai][bj][m][n]; s += (x[0] + x[1]) + (x[2] + x[3]); }
                s += __shfl_xor(s, 16); s += __shfl_xor(s, 32);
                const float mw = s * (1.0f / 64.0f); float q = 0.f;
#pragma unroll
                for (int bj = 0; bj < 2; ++bj)
#pragma unroll
                    for (int n = 0; n < 2; ++n) { const f32x4 d = v[ai][bj][m][n] - mw; q += (d[0] * d[0] + d[1] * d[1]) + (d[2] * d[2] + d[3] * d[3]); }
                q += __shfl_xor(q, 16); q += __shfl_xor(q, 32);
                if (fq == 0) P[(ai * HALF + wr * 64 + m * 16 + fr) * 4 + wc] = (f32x2v){mw, q};
            }
        asm volatile("s_waitcnt lgkmcnt(0)" ::: "memory"); __builtin_amdgcn_s_barrier(); asm volatile("" ::: "memory");
#if defined(BROKEN_EXCHANGE_NO_WAIT)
#warning BROKEN CONTROL BUILD: the row-statistics exchange does not wait; results are wrong by design
        if (blockIdx.x >= 64) { const long long t0_ = clock64(); while (clock64() - t0_ < 60000) __builtin_amdgcn_s_sleep(8); }
#endif
        const int row = wid * 32 + (lane & 31);
        if (lane < 32) {
            const f32x2v a = P[row * 4 + 0], b = P[row * 4 + 1], c = P[row * 4 + 2], d = P[row * 4 + 3];
            const float mt = (a.x + b.x + c.x + d.x) * 0.25f;
            const float da = a.x - mt, db = b.x - mt, dc = c.x - mt, dd = d.x - mt;
            const float m2 = (a.y + b.y) + (c.y + d.y) + 64.0f * ((da * da + db * db) + (dc * dc + dd * dd));
            unsigned long long* slot = (unsigned long long*)xbuf + ((size_t)(u.pm * BM + row) * 4 + u.pn);
            __hip_atomic_store(slot, ((unsigned long long)__float_as_uint(m2) << 32) | __float_as_uint(mt), __ATOMIC_RELAXED, __HIP_MEMORY_SCOPE_AGENT);
        }
        asm volatile("s_waitcnt vmcnt(0)" ::: "memory");
        if (lane == 0) __hip_atomic_fetch_add(cnt + 64 * u.pm, 1u, __ATOMIC_RELAXED, __HIP_MEMORY_SCOPE_AGENT);
        if (wid == 0) {
            bool dead = false; const unsigned long long t0 = __builtin_amdgcn_s_memrealtime(); const unsigned want = 8u * (unsigned)ntn;
            for (;;) {
#if defined(BROKEN_EXCHANGE_NO_WAIT)
                break;
#endif
                if ((unsigned)__builtin_amdgcn_readfirstlane(__hip_atomic_load(cnt + 64 * u.pm, __ATOMIC_RELAXED, __HIP_MEMORY_SCOPE_AGENT)) >= want) break;
                if (__builtin_amdgcn_s_memrealtime() - t0 > 2000000ull) {
                    if (lane == 0) { unsigned expect = 0u; __hip_atomic_compare_exchange_strong(tmo + 1, &expect, code | (unsigned)(u.pm & 0xff), __ATOMIC_RELAXED, __ATOMIC_RELAXED, __HIP_MEMORY_SCOPE_AGENT);
                                     __hip_atomic_store(tmo, 1u, __ATOMIC_RELAXED, __HIP_MEMORY_SCOPE_AGENT); }
                    dead = true; break; }
                __builtin_amdgcn_s_sleep(2);
            }
            __builtin_amdgcn_fence(__ATOMIC_ACQUIRE, "agent");
            if (lane == 0) flag[0] = dead ? 1u : 0u;
        }
        asm volatile("s_waitcnt vmcnt(0) lgkmcnt(0)" ::: "memory"); __builtin_amdgcn_s_barrier(); asm volatile("" ::: "memory");
        const bool bad = flag[0] != 0u;
        if (lane < 32) {
            const unsigned long long* slot = (const unsigned long long*)xbuf + (size_t)(u.pm * BM + row) * 4; float mt[4], m2[4]; float ms = 0.f;
#pragma unroll
            for (int t = 0; t < 4; ++t) { if (t < ntn) { const unsigned long long w = __hip_atomic_load(slot + t, __ATOMIC_RELAXED, __HIP_MEMORY_SCOPE_AGENT); mt[t] = __uint_as_float((unsigned)w); m2[t] = __uint_as_float((unsigned)(w >> 32)); } else { mt[t] = 0.f; m2[t] = 0.f; } ms += mt[t]; }
            const float mean = ms / (float)ntn; float q = 0.f;
#pragma unroll
            for (int t = 0; t < 4; ++t) if (t < ntn) { const float dm = mt[t] - mean; q += m2[t] + 256.0f * dm * dm; }
            S[row] = (f32x2v){mean, 1.0f / sqrtf(q / (256.0f * (float)ntn) + eps)};
        }
        asm volatile("s_waitcnt lgkmcnt(0)" ::: "memory"); __builtin_amdgcn_s_barrier(); asm volatile("" ::: "memory");
        return bad;
    }
};
struct EpiLnRes {
    static constexpr bool PERM = false, AFTER_DRAIN = true;
    const float* base; float* out; int ldc; const float* bias; PanelStats st; unsigned poison;
    __device__ __forceinline__ void fused(f32x4 (&acc)[2][2][4][2], const Unit& u, int wr, int wc, int fr, int fq, PG8_LAS unsigned char* lds, int wid, int lane) const {
        typedef float f32x2v __attribute__((ext_vector_type(2)));
        const PG8_LAS f32x2v* S = (const PG8_LAS f32x2v*)(lds + 8192);
        const int col0 = u.pn * BM + wc * 32 + 4 * fq;
#pragma unroll
        for (int bj = 0; bj < 2; ++bj)
#pragma unroll
            for (int n = 0; n < 2; ++n) { const f32x4 bv = bias ? *(const f32x4*)(bias + col0 + bj * HALF + n * 16) : (f32x4){0.f, 0.f, 0.f, 0.f};
#pragma unroll
                for (int ai = 0; ai < 2; ++ai)
#pragma unroll
                    for (int m = 0; m < 4; ++m) acc[ai][bj][m][n] += bv; }
        f32x4 pre[4][2][2];
#pragma unroll
        for (int m = 0; m < 4; ++m) { const size_t off = (size_t)(u.pm * BM + wr * 64 + m * 16 + fr) * ldc + col0;
#pragma unroll
            for (int bj = 0; bj < 2; ++bj)
#pragma unroll
                for (int n = 0; n < 2; ++n) pre[m][bj][n] = *(const f32x4*)(base + off + bj * HALF + n * 16); }
        const bool bad = st.run(acc, u, wr, wc, fr, fq, lds, wid, lane) || poison != 0u;
        const float qnan = __builtin_nanf("");
#pragma unroll
        for (int ai = 0; ai < 2; ++ai)
#pragma unroll
            for (int m = 0; m < 4; ++m) { const int r = ai * HALF + wr * 64 + m * 16 + fr; const f32x2v sr = S[r]; const size_t off = (size_t)(u.pm * BM + r) * ldc + col0;
#pragma unroll
                for (int bj = 0; bj < 2; ++bj)
#pragma unroll
                    for (int n = 0; n < 2; ++n) { const f32x4 bs = ai == 0 ? pre[m][bj][n] : *(const f32x4*)(base + off + bj * HALF + n * 16); f32x4 o = bs + (acc[ai][bj][m][n] - sr.x) * sr.y;
                        if (bad) o = (f32x4){qnan, qnan, qnan, qnan}; *(f32x4*)(out + off + bj * HALF + n * 16) = o; }
                if (m & 1) asm volatile("" ::: "memory"); }
    }
};
struct EpiLnResLn {
    static constexpr bool PERM = false, AFTER_DRAIN = true;
    const float* base; float* out; bf16_t* xn; int ldc; const float* bias; PanelStats st1, st2; unsigned poison;
    __device__ __forceinline__ void fused(f32x4 (&acc)[2][2][4][2], const Unit& u, int wr, int wc, int fr, int fq, PG8_LAS unsigned char* lds, int wid, int lane) const {
        typedef float f32x2v __attribute__((ext_vector_type(2))); typedef unsigned u32x2v __attribute__((ext_vector_type(2)));
        const PG8_LAS f32x2v* S = (const PG8_LAS f32x2v*)(lds + 8192);
        const int col0 = u.pn * BM + wc * 32 + 4 * fq;
#pragma unroll
        for (int bj = 0; bj < 2; ++bj)
#pragma unroll
            for (int n = 0; n < 2; ++n) { const f32x4 bv = bias ? *(const f32x4*)(bias + col0 + bj * HALF + n * 16) : (f32x4){0.f, 0.f, 0.f, 0.f};
#pragma unroll
                for (int ai = 0; ai < 2; ++ai)
#pragma unroll
                    for (int m = 0; m < 4; ++m) acc[ai][bj][m][n] += bv; }
        bool bad = st1.run(acc, u, wr, wc, fr, fq, lds, wid, lane) || poison != 0u;
        const float qnan = __builtin_nanf("");
#pragma unroll
        for (int ai = 0; ai < 2; ++ai)
#pragma unroll
            for (int m = 0; m < 4; ++m) { const int r = ai * HALF + wr * 64 + m * 16 + fr; const f32x2v sr = S[r]; const size_t off = (size_t)(u.pm * BM + r) * ldc + col0;
#pragma unroll
                for (int bj = 0; bj < 2; ++bj)
#pragma unroll
                    for (int n = 0; n < 2; ++n) { const f32x4 bs = *(const f32x4*)(base + off + bj * HALF + n * 16); acc[ai][bj][m][n] = bs + (acc[ai][bj][m][n] - sr.x) * sr.y; }
                asm volatile("" : "+v"(acc[ai][0][m][0]), "+v"(acc[ai][0][m][1]), "+v"(acc[ai][1][m][0]), "+v"(acc[ai][1][m][1]));
                if (m & 1) asm volatile("" ::: "memory"); }
        const bool bad1 = bad;
        bad = st2.run(acc, u, wr, wc, fr, fq, lds, wid, lane) || bad;
#pragma unroll
        for (int ai = 0; ai < 2; ++ai)
#pragma unroll
            for (int m = 0; m < 4; ++m) { const int r = ai * HALF + wr * 64 + m * 16 + fr; const f32x2v sr = S[r]; const size_t off = (size_t)(u.pm * BM + r) * ldc + col0;
#pragma unroll
                for (int bj = 0; bj < 2; ++bj)
#pragma unroll
                    for (int n = 0; n < 2; ++n) { const f32x4 x1 = acc[ai][bj][m][n]; *(f32x4*)(out + off + bj * HALF + n * 16) = bad1 ? (f32x4){qnan, qnan, qnan, qnan} : x1;
                        const f32x4 o = (x1 - sr.x) * sr.y; u32x2v w; w.x = cvt_pk_bf16(o[0], o[1]); w.y = cvt_pk_bf16(o[2], o[3]);
                        if (bad) { w.x = 0x7fc07fc0u; w.y = 0x7fc07fc0u; } *(u32x2v*)(xn + off + bj * HALF + n * 16) = w; }
                asm volatile("" ::: "memory"); }
    }
};

template <class Epi, class Sched, bool ALIGN_EPI = false, bool SP2 = false>
__device__ __forceinline__ void gemm_phase(PG8_LAS unsigned char* lds, const Gemm g, const Sched& S, const Epi& E) {
    const int tid = threadIdx.x, wid = __builtin_amdgcn_readfirstlane(tid >> 6), lane = tid & 63, wr = wid >> 2, wc = wid & 3, fr = lane & 15, fq = lane >> 4;
    const int K = g.K, nt = K / BK;
    unsigned voffA[2], voffB[2];
#pragma unroll
    for (int i = 0; i < 2; ++i) { int R, C; stage_rc(tid * 16 + i * 8192, R, C); const int Rb = Epi::PERM ? ((R & ~31) + perm32(R & 31)) : R;
        voffA[i] = (unsigned)(R * K + C) * 2u; voffB[i] = (unsigned)(Rb * K + C) * 2u; }
    const size_t kstep = (size_t)(BK * 2);
    const size_t hstep = (size_t)HALF * K * 2;
    const size_t tstep = 2 * hstep;
    const unsigned ldsw = (unsigned)wid * 1024u;
    const int aoff = lds_byte(wr * 64 + fr, fq * 8), boff = lds_byte(wc * 32 + fr, fq * 8);
#define PG8_SA(b, h) (((b) * 2 + (h)) * HTB)
#define PG8_SB(b, h) ((4 + (b) * 2 + (h)) * HTB)
#define PG8_STAGE(bufoff, gbase, voff) do { _Pragma("unroll") for (int _i = 0; _i < 2; ++_i) \
        __builtin_amdgcn_global_load_lds((const unsigned*)((const char*)(gbase) + (voff)[_i]), (PG8_LAS unsigned*)(lds + (bufoff) + ldsw + _i * 8192), 16, 0, 0); } while (0)
#define PG8_LDA(dst, b, h) do { _Pragma("unroll") for (int m = 0; m < 4; ++m) _Pragma("unroll") for (int k = 0; k < 2; ++k) dst[m][k] = *(const PG8_LAS bf16x8*)(lds + PG8_SA(b, h) + aoff + m * 2048 + k * 1024); } while (0)
#define PG8_LDB(dst, b, h) do { _Pragma("unroll") for (int n = 0; n < 2; ++n) _Pragma("unroll") for (int k = 0; k < 2; ++k) dst[n][k] = *(const PG8_LAS bf16x8*)(lds + PG8_SB(b, h) + boff + n * 2048 + k * 1024); } while (0)
#define PG8_MMA(ai, bj, At, Bt) do { __builtin_amdgcn_s_setprio(1); _Pragma("unroll") for (int m = 0; m < 4; ++m) _Pragma("unroll") for (int n = 0; n < 2; ++n) _Pragma("unroll") for (int k = 0; k < 2; ++k) \
        acc[ai][bj][m][n] = __builtin_amdgcn_mfma_f32_16x16x32_bf16(Bt[n][k], At[m][k], acc[ai][bj][m][n], 0, 0, 0); __builtin_amdgcn_s_setprio(0); } while (0)
#define PG8_WAIT_V(n) asm volatile("s_waitcnt vmcnt(" #n ")" ::: "memory")
#define PG8_WAIT_L(n) asm volatile("s_waitcnt lgkmcnt(" #n ")" ::: "memory")
#define PG8_BAR __builtin_amdgcn_s_barrier()
#define PG8_SCHED __builtin_amdgcn_sched_barrier(0)
    Unit cur, nxt; int ui = 0;
    if (!S.next(0, cur)) return;
    f32x4 acc[2][2][4][2];
#pragma unroll
    for (int a = 0; a < 2; ++a)
#pragma unroll
        for (int b = 0; b < 2; ++b)
#pragma unroll
            for (int m = 0; m < 4; ++m)
#pragma unroll
                for (int n = 0; n < 2; ++n) acc[a][b][m][n] = (f32x4){0.f, 0.f, 0.f, 0.f};
    bf16x8 At[4][2], B0[2][2], B1[2][2];
    const char* cA = (const char*)g.A + (size_t)cur.pm * tstep; const char* cB = (const char*)g.Bt + (size_t)cur.pn * tstep;
    S.a_ready(cur);
    if constexpr (SP2) {
        PG8_STAGE(PG8_SB(0, 0), cB, voffB); PG8_STAGE(PG8_SB(0, 1), cB + hstep, voffB); PG8_STAGE(PG8_SA(0, 0), cA, voffA); PG8_STAGE(PG8_SA(0, 1), cA + hstep, voffA);
        if (wr == 1) PG8_BAR;
        PG8_WAIT_V(2); PG8_BAR;
        PG8_STAGE(PG8_SB(1, 0), cB + kstep, voffB); PG8_STAGE(PG8_SA(1, 0), cA + kstep, voffA); PG8_STAGE(PG8_SB(1, 1), cB + hstep + kstep, voffB);
        PG8_WAIT_V(6); PG8_BAR;
    } else {
        PG8_STAGE(PG8_SB(0, 0), cB, voffB); PG8_STAGE(PG8_SA(0, 0), cA, voffA); PG8_STAGE(PG8_SB(0, 1), cB + hstep, voffB); PG8_STAGE(PG8_SA(0, 1), cA + hstep, voffA);
        if (wr == 1) PG8_BAR;
        PG8_WAIT_V(4); PG8_BAR;
        PG8_STAGE(PG8_SB(1, 0), cB + kstep, voffB); PG8_STAGE(PG8_SA(1, 0), cA + kstep, voffA); PG8_STAGE(PG8_SB(1, 1), cB + hstep + kstep, voffB);
        PG8_WAIT_V(6); PG8_BAR;
    }
    for (;;) {
        const bool has_next = S.next(ui + 1, nxt);
        const char* nA = has_next ? (const char*)g.A + (size_t)nxt.pm * tstep : cA; const char* nB = has_next ? (const char*)g.Bt + (size_t)nxt.pn * tstep : cB;
        for (int t = 0; t < nt; t += 2) {
            const bool last = (t == nt - 2);
            const char* a1 = cA + (size_t)(t + 1) * kstep;
            const char* a2 = last ? nA : cA + (size_t)(t + 2) * kstep; const char* b2 = last ? nB : cB + (size_t)(t + 2) * kstep;
            const char* a3 = a2 + kstep; const char* b3 = b2 + kstep;
            if (last && has_next) S.a_ready(nxt);
            if constexpr (SP2) {
            PG8_LDB(B0, 0, 0); PG8_LDB(B1, 0, 1); PG8_SCHED; PG8_LDA(At, 0, 0); PG8_STAGE(PG8_SA(1, 1), a1 + hstep, voffA);
            PG8_WAIT_V(8); PG8_WAIT_L(0); PG8_BAR; PG8_MMA(0, 0, At, B0); PG8_MMA(0, 1, At, B1); PG8_BAR; PG8_SCHED;
            PG8_LDA(At, 0, 1); PG8_STAGE(PG8_SB(0, 0), b2, voffB); PG8_STAGE(PG8_SB(0, 1), b2 + hstep, voffB); PG8_STAGE(PG8_SA(0, 0), a2, voffA);
            PG8_WAIT_V(8); PG8_WAIT_L(0); PG8_BAR; PG8_MMA(1, 0, At, B0); PG8_MMA(1, 1, At, B1); PG8_BAR; PG8_SCHED;
            PG8_LDB(B0, 1, 0); PG8_LDB(B1, 1, 1); PG8_SCHED; PG8_LDA(At, 1, 0); PG8_STAGE(PG8_SA(0, 1), a2 + hstep, voffA);
            PG8_WAIT_V(8); PG8_WAIT_L(0); PG8_BAR; PG8_MMA(0, 0, At, B0); PG8_MMA(0, 1, At, B1); PG8_BAR; PG8_SCHED;
            PG8_LDA(At, 1, 1); PG8_STAGE(PG8_SB(1, 0), b3, voffB); PG8_STAGE(PG8_SB(1, 1), b3 + hstep, voffB); PG8_STAGE(PG8_SA(1, 0), a3, voffA);
            PG8_WAIT_V(8); PG8_WAIT_L(0); PG8_BAR; PG8_MMA(1, 0, At, B0); PG8_MMA(1, 1, At, B1); PG8_BAR; PG8_SCHED;
            } else {
            PG8_LDB(B0, 0, 0); PG8_SCHED; PG8_LDA(At, 0, 0); PG8_STAGE(PG8_SA(1, 1), a1 + hstep, voffA);
            PG8_WAIT_L(8); PG8_BAR; PG8_WAIT_L(0); PG8_MMA(0, 0, At, B0); PG8_BAR; PG8_SCHED;
            PG8_LDB(B1, 0, 1); PG8_STAGE(PG8_SB(0, 0), b2, voffB);
            PG8_BAR; PG8_WAIT_L(0); PG8_MMA(0, 1, At, B1); PG8_BAR;
            PG8_LDA(At, 0, 1); PG8_STAGE(PG8_SA(0, 0), a2, voffA);
            PG8_BAR; PG8_WAIT_L(0); PG8_MMA(1, 0, At, B0); PG8_BAR; PG8_SCHED;
            PG8_STAGE(PG8_SB(0, 1), b2 + hstep, voffB);
            PG8_WAIT_V(6); PG8_BAR; PG8_MMA(1, 1, At, B1); PG8_BAR;
            PG8_LDB(B0, 1, 0); PG8_SCHED; PG8_LDA(At, 1, 0); PG8_STAGE(PG8_SA(0, 1), a2 + hstep, voffA);
            PG8_WAIT_L(8); PG8_BAR; PG8_WAIT_L(0); PG8_MMA(0, 0, At, B0); PG8_BAR; PG8_SCHED;
            PG8_LDB(B1, 1, 1); PG8_STAGE(PG8_SB(1, 0), b3, voffB);
            PG8_BAR; PG8_WAIT_L(0); PG8_MMA(0, 1, At, B1); PG8_BAR;
            PG8_LDA(At, 1, 1); PG8_STAGE(PG8_SA(1, 0), a3, voffA);
            PG8_BAR; PG8_WAIT_L(0); PG8_MMA(1, 0, At, B0); PG8_BAR; PG8_SCHED;
            PG8_STAGE(PG8_SB(1, 1), b3 + hstep, voffB);
            PG8_WAIT_V(6); PG8_BAR; PG8_MMA(1, 1, At, B1); PG8_BAR;
            }
        }
        if constexpr (ALIGN_EPI) { if (wr == 0) PG8_BAR; }
        if constexpr (!Epi::AFTER_DRAIN) { E(acc, cur, wr, wc, fr, fq); S.done(cur); }
        if (!has_next) break;
#pragma unroll
        for (int a = 0; a < 2; ++a)
#pragma unroll
            for (int b = 0; b < 2; ++b)
#pragma unroll
                for (int m = 0; m < 4; ++m)
#pragma unroll
                    for (int n = 0; n < 2; ++n) acc[a][b][m][n] = (f32x4){0.f, 0.f, 0.f, 0.f};
        cur = nxt; cA = nA; cB = nB; ++ui;
        if constexpr (ALIGN_EPI) { if (wr == 1) PG8_BAR; }
    }
    PG8_WAIT_V(0);
    if constexpr (!ALIGN_EPI) { if (wr == 0) PG8_BAR; }
    PG8_BAR;
    if constexpr (Epi::AFTER_DRAIN) { E.fused(acc, cur, wr, wc, fr, fq, lds, wid, lane); S.done(cur); }
#undef PG8_SA
#undef PG8_SB
#undef PG8_STAGE
#undef PG8_LDA
#undef PG8_LDB
#undef PG8_MMA
#undef PG8_WAIT_V
#undef PG8_WAIT_L
#undef PG8_BAR
#undef PG8_SCHED
}
}
constexpr int NWAVES = 8;
constexpr int BATCH = 8, T = 2048, DM = 2048, M = BATCH * T;
constexpr int AH = 8, BH = 8, QLORA = 512, KVLORA = 256;
constexpr int DIN = 5952, NIN = 6144;
constexpr float EPS = 1e-6f;
constexpr float LOG2E = 1.4426950408889634f;
constexpr float ASCALE = 0.08838834764831845f * LOG2E;
constexpr float BSCALE = 0.07216878364870323f * LOG2E;
typedef float f32x2 __attribute__((ext_vector_type(2)));

namespace pg8 {
__device__ __forceinline__ float silu_f(float v) { return v * __builtin_amdgcn_rcpf(1.0f + __builtin_amdgcn_exp2f(-v * 1.4426950408889634f)); }
__device__ __forceinline__ u32x4 pack8(const f32x4& v0, const f32x4& v1) { u32x4 w; w.x = cvt_pk_bf16(v0[0], v0[1]); w.y = cvt_pk_bf16(v0[2], v0[3]); w.z = cvt_pk_bf16(v1[0], v1[1]); w.w = cvt_pk_bf16(v1[2], v1[3]); return w; }
__device__ __forceinline__ void rope8(f32x4& v0, f32x4& v1, const f32x2* rope, int t, int j0) {
    const f32x4 c01 = *(const f32x4*)(rope + t * 32 + j0), c23 = *(const f32x4*)(rope + t * 32 + j0 + 2);
    f32x4 o0, o1;
    o0[0] = v0[0] * c01[0] - v0[1] * c01[1]; o0[1] = v0[0] * c01[1] + v0[1] * c01[0];
    o0[2] = v0[2] * c01[2] - v0[3] * c01[3]; o0[3] = v0[2] * c01[3] + v0[3] * c01[2];
    o1[0] = v1[0] * c23[0] - v1[1] * c23[1]; o1[1] = v1[0] * c23[1] + v1[1] * c23[0];
    o1[2] = v1[2] * c23[2] - v1[3] * c23[3]; o1[3] = v1[2] * c23[3] + v1[3] * c23[2];
    v0 = o0; v1 = o1;
}
struct EpiProj {
    static constexpr bool PERM = true, AFTER_DRAIN = false;
    bf16_t *AQ, *AK, *AV, *AZ, *BZ, *CQ, *CKV, *KPE; float *ssq_q, *ssq_kv; const f32x2* rope;
    __device__ __forceinline__ void operator()(const f32x4 (&acc)[2][2][4][2], const Unit& u, int wr, int wc, int fr, int fq) const {
        const int pn = u.pn, row0 = u.pm * BM + wr * 64 + fr, cl0 = wc * 32 + 8 * fq;
        if (pn < 20) {
            bf16_t* base; int ct; float sc = 1.f; bool act = false;
            if (pn < 4) { base = AQ; ct = pn; sc = ASCALE; } else if (pn < 8) { base = AK; ct = pn - 4; } else if (pn < 12) { base = AV; ct = pn - 8; }
            else if (pn < 16) { base = AZ; ct = pn - 12; act = true; } else { base = BZ; ct = pn - 16; act = true; }
#pragma unroll
            for (int ai = 0; ai < 2; ++ai)
#pragma unroll
                for (int m = 0; m < 4; ++m) { bf16_t* rowp = base + (size_t)(row0 + ai * HALF + m * 16) * 1024 + ct * 256 + cl0;
#pragma unroll
                    for (int bj = 0; bj < 2; ++bj) { f32x4 v0 = acc[ai][bj][m][0], v1 = acc[ai][bj][m][1];
                        if (act) {
#pragma unroll
                            for (int e = 0; e < 4; ++e) { v0[e] = silu_f(v0[e]); v1[e] = silu_f(v1[e]); } }
                        else { v0 = v0 * sc; v1 = v1 * sc; }
                        *(u32x4*)(rowp + bj * HALF) = pack8(v0, v1); } }
        } else if (pn < 23) {
            bf16_t* base; int ld, ct, ns; float* ssq;
            if (pn < 22) { base = CQ; ld = 512; ct = pn - 20; ssq = ssq_q; ns = 8; } else { base = CKV; ld = 256; ct = 0; ssq = ssq_kv; ns = 4; }
#pragma unroll
            for (int ai = 0; ai < 2; ++ai)
#pragma unroll
                for (int m = 0; m < 4; ++m) { const int row = row0 + ai * HALF + m * 16; bf16_t* rowp = base + (size_t)row * ld + ct * 256 + cl0; float s = 0.f;
#pragma unroll
                    for (int bj = 0; bj < 2; ++bj) { const f32x4 v0 = acc[ai][bj][m][0], v1 = acc[ai][bj][m][1];
                        s += (v0[0] * v0[0] + v0[1] * v0[1]) + (v0[2] * v0[2] + v0[3] * v0[3]) + (v1[0] * v1[0] + v1[1] * v1[1]) + (v1[2] * v1[2] + v1[3] * v1[3]);
                        *(u32x4*)(rowp + bj * HALF) = pack8(v0, v1); }
                    s += __shfl_xor(s, 16); s += __shfl_xor(s, 32);
                    if (fq == 0) ssq[(size_t)row * ns + ct * 4 + wc] = s; }
        } else {
            if (wc < 2) {
#pragma unroll
                for (int ai = 0; ai < 2; ++ai)
#pragma unroll
                    for (int m = 0; m < 4; ++m) { const int row = row0 + ai * HALF + m * 16; f32x4 v0 = acc[ai][0][m][0], v1 = acc[ai][0][m][1];
                        rope8(v0, v1, rope, row & (T - 1), cl0 >> 1);
                        *(u32x4*)(KPE + (size_t)row * 64 + cl0) = pack8(v0, v1); }
            }
        }
    }
};
struct EpiUpQ {
    static constexpr bool PERM = true, AFTER_DRAIN = false;
    bf16_t* Q; const float* ssq; const f32x2* rope;
    __device__ __forceinline__ void operator()(const f32x4 (&acc)[2][2][4][2], const Unit& u, int wr, int wc, int fr, int fq) const {
        const int row0 = u.pm * BM + wr * 64 + fr, c0 = u.pn * BM + wc * 32 + 8 * fq;
#pragma unroll
        for (int ai = 0; ai < 2; ++ai)
#pragma unroll
            for (int m = 0; m < 4; ++m) { const int row = row0 + ai * HALF + m * 16;
                const f32x4 sa = *(const f32x4*)(ssq + (size_t)row * 8), sb = *(const f32x4*)(ssq + (size_t)row * 8 + 4);
                const float ss = ((sa[0] + sa[1]) + (sa[2] + sa[3])) + ((sb[0] + sb[1]) + (sb[2] + sb[3]));
                const float rs = BSCALE / sqrtf(ss * (1.0f / 512.0f) + EPS);
#pragma unroll
                for (int bj = 0; bj < 2; ++bj) { const int c = c0 + bj * HALF, w = c % 192; f32x4 v0 = acc[ai][bj][m][0] * rs, v1 = acc[ai][bj][m][1] * rs;
                    if (w >= 128) rope8(v0, v1, rope, row & (T - 1), (w - 128) >> 1);
                    *(u32x4*)(Q + (size_t)row * 1536 + c) = pack8(v0, v1); } }
    }
};
struct EpiUpKV {
    static constexpr bool PERM = true, AFTER_DRAIN = false;
    bf16_t *KN, *V; const float* ssq;
    __device__ __forceinline__ void operator()(const f32x4 (&acc)[2][2][4][2], const Unit& u, int wr, int wc, int fr, int fq) const {
        const int row0 = u.pm * BM + wr * 64 + fr, cl0 = wc * 32 + 8 * fq; bf16_t* base = u.pn < 4 ? KN : V; const int ct = u.pn & 3;
#pragma unroll
        for (int ai = 0; ai < 2; ++ai)
#pragma unroll
            for (int m = 0; m < 4; ++m) { const int row = row0 + ai * HALF + m * 16;
                const f32x4 sa = *(const f32x4*)(ssq + (size_t)row * 4);
                const float rs = 1.0f / sqrtf(((sa[0] + sa[1]) + (sa[2] + sa[3])) * (1.0f / 256.0f) + EPS);
#pragma unroll
                for (int bj = 0; bj < 2; ++bj) { const f32x4 v0 = acc[ai][bj][m][0] * rs, v1 = acc[ai][bj][m][1] * rs;
                    *(u32x4*)(base + (size_t)row * 1024 + ct * 256 + bj * HALF + cl0) = pack8(v0, v1); } }
    }
};
struct EpiOut {
    static constexpr bool PERM = true, AFTER_DRAIN = false;
    bf16_t* Y2; float* ssq;
    __device__ __forceinline__ void operator()(const f32x4 (&acc)[2][2][4][2], const Unit& u, int wr, int wc, int fr, int fq) const {
        const int row0 = u.pm * BM + wr * 64 + fr, cl0 = wc * 32 + 8 * fq;
#pragma unroll
        for (int ai = 0; ai < 2; ++ai)
#pragma unroll
            for (int m = 0; m < 4; ++m) { const int row = row0 + ai * HALF + m * 16; bf16_t* rowp = Y2 + (size_t)row * 2048 + u.pn * 256 + cl0; float s = 0.f;
#pragma unroll
                for (int bj = 0; bj < 2; ++bj) { const f32x4 v0 = acc[ai][bj][m][0], v1 = acc[ai][bj][m][1];
                    s += (v0[0] * v0[0] + v0[1] * v0[1]) + (v0[2] * v0[2] + v0[3] * v0[3]) + (v1[0] * v1[0] + v1[1] * v1[1]) + (v1[2] * v1[2] + v1[3] * v1[3]);
                    *(u32x4*)(rowp + bj * HALF) = pack8(v0, v1); }
                s += __shfl_xor(s, 16); s += __shfl_xor(s, 32);
                if (fq == 0) ssq[(size_t)row * 32 + u.pn * 4 + wc] = s; }
    }
};
}
#define GAS __attribute__((address_space(1)))
#define LAS __attribute__((address_space(3)))
typedef unsigned short bf16;
typedef unsigned v4u __attribute__((ext_vector_type(4)));
typedef float f32x4 __attribute__((ext_vector_type(4)));
typedef short bf16x8 __attribute__((ext_vector_type(8)));
typedef GAS unsigned gu32;
typedef GAS unsigned long long gu64;
#define RLX_AGENT __ATOMIC_RELAXED, __HIP_MEMORY_SCOPE_AGENT
#define LDS_WAIT() asm volatile("s_waitcnt lgkmcnt(0)" ::: "memory")
#define VM_WAIT() asm volatile("s_waitcnt vmcnt(0)" ::: "memory")
__device__ __forceinline__ unsigned long long rt() { return __builtin_amdgcn_s_memrealtime(); }
__device__ __forceinline__ unsigned f2bf(float f) { unsigned u = __builtin_bit_cast(unsigned, f); return (u + 0x7fffu + ((u >> 16) & 1u)) >> 16; }
__device__ __forceinline__ unsigned pk2(float lo, float hi) { return f2bf(lo) | (f2bf(hi) << 16); }

#define XB_TMO      128
#define XB_XCNT(j)  (256  + 64 * (j))
#define XB_XSUB(j)  (1280 + 64 * (j))
#define XB_XGEN(j)  (2304 + 64 * (j))
#define XB_TOP      3328
#define XB_TOPGEN   3392
#define XCD_BAR_WORDS 3456
#define XB_SPIN_CAP (1u << 21)

__device__ __forceinline__ unsigned xb_ld(unsigned* p)              { return __hip_atomic_load(p, __ATOMIC_RELAXED, __HIP_MEMORY_SCOPE_AGENT); }
__device__ __forceinline__ unsigned xb_add(unsigned* p, unsigned v) { return __hip_atomic_fetch_add(p, v, __ATOMIC_RELAXED, __HIP_MEMORY_SCOPE_AGENT); }
__device__ __forceinline__ unsigned xb_xcc_id() { return (unsigned)__builtin_amdgcn_s_getreg((3 << 11) | 20) & 0xFu; }
#define XB_SPIN(cond, bar) do { unsigned _sp = 0; while (cond) { __builtin_amdgcn_s_sleep(1); \
    if ((++_sp & 255u) == 0u) { if (xb_ld(&(bar)[XB_TMO])) break; if (_sp > XB_SPIN_CAP) { atomicAdd(&(bar)[XB_TMO], 1u); break; } } } } while (0)

struct XcdBarrier {
    unsigned* bar; unsigned x;
    volatile LAS unsigned* st;
};

__device__ __forceinline__ XcdBarrier xcd_barrier_post(unsigned* bar, volatile LAS unsigned* st) {
    XcdBarrier b; b.bar = bar; b.x = xb_xcc_id(); b.st = st;
    if (threadIdx.x == 0) (void)xb_add(&bar[XB_XCNT(b.x)], 1u);
    return b;
}
__device__ __forceinline__ void xcd_barrier_complete(unsigned* bar, unsigned x, unsigned& nloc, unsigned& nx) {
    const unsigned G = gridDim.x * gridDim.y * gridDim.z;
    unsigned sum, cnt, mine, sp = 0u;
    for (;;) {
        sum = 0u; cnt = 0u; mine = 0u;
#pragma unroll
        for (unsigned j = 0; j < 16; ++j) { const unsigned c = xb_ld(&bar[XB_XCNT(j)]); sum += c; cnt += (c > 0u) ? 1u : 0u; mine = (j == x) ? c : mine; }
        if (sum == G) break;
        __builtin_amdgcn_s_sleep(1);
        if ((++sp & 255u) == 0u) { if (xb_ld(&bar[XB_TMO])) break; if (sp > XB_SPIN_CAP) { atomicAdd(&bar[XB_TMO], 1u); break; } }
    }
    nloc = mine > 0u ? mine : 1u; nx = cnt > 0u ? cnt : 1u;
}

__device__ __forceinline__ void xcd_barrier(const XcdBarrier& b) {
    asm volatile("s_waitcnt vmcnt(0)" ::: "memory");
    __syncthreads();
    if (threadIdx.x == 0) {
        unsigned* bar = b.bar;
        __builtin_amdgcn_s_waitcnt(0);
        unsigned nloc = b.st[0], nx = b.st[1];
        if (nloc == 0u) { xcd_barrier_complete(bar, b.x, nloc, nx); b.st[0] = nloc; b.st[1] = nx; }
        const unsigned old = xb_add(&bar[XB_XSUB(b.x)], 1u);
        const unsigned gen = old / nloc;
        if (old + 1u == (gen + 1u) * nloc) {
            __builtin_amdgcn_fence(__ATOMIC_RELEASE, "agent");
            asm volatile("s_waitcnt vmcnt(0)" ::: "memory");
            const unsigned og = xb_add(&bar[XB_TOP], 1u);
            const unsigned tg = og / nx;
            if (og + 1u == (tg + 1u) * nx) xb_add(&bar[XB_TOPGEN], 1u);
            else XB_SPIN(xb_ld(&bar[XB_TOPGEN]) == tg, bar);
            __builtin_amdgcn_fence(__ATOMIC_ACQUIRE, "agent");
            xb_add(&bar[XB_XGEN(b.x)], 1u);
            asm volatile("s_waitcnt vmcnt(0)" ::: "memory");
        } else {
            XB_SPIN(xb_ld(&bar[XB_XGEN(b.x)]) == gen, bar);
            __builtin_amdgcn_fence(__ATOMIC_ACQUIRE, "agent");
            asm volatile("s_waitcnt vmcnt(0)" ::: "memory");
        }
    }
    __syncthreads();
}
constexpr size_t MiB = 1u << 20;
constexpr size_t WS_CTL = 0, CTL_ZERO_BYTES = 1 * MiB;
constexpr size_t WS_ROPE = 1 * MiB;
constexpr size_t WS_MODP = 2 * MiB;
constexpr size_t WS_WIN = 4 * MiB, WS_WOUT = 28 * MiB, WS_WUQ = 36 * MiB, WS_WUKV = 38 * MiB;
constexpr size_t WS_H = 40 * MiB, WS_Y = 40 * MiB;
constexpr size_t WS_AQ = 104 * MiB, WS_AK = 136 * MiB, WS_AV = 168 * MiB, WS_AZ = 200 * MiB, WS_BZ = 232 * MiB;
constexpr size_t WS_CQ = 264 * MiB, WS_CKV = 280 * MiB, WS_KPE = 288 * MiB;
constexpr size_t WS_Q = 290 * MiB, WS_KN = 338 * MiB, WS_V = 370 * MiB;
constexpr size_t WS_Y2 = 402 * MiB;
constexpr size_t WS_SSQQ = 466 * MiB, WS_SSQKV = 467 * MiB, WS_SSQY = 468 * MiB, WS_END = 470 * MiB;
constexpr int CW_BAR = 4096;

constexpr int RING_OFF = 0, RING_BYTES = 131072;
constexpr int LDSCTL_OFF = RING_BYTES, MISC_OFF = LDSCTL_OFF + 320;
constexpr int LDS_BYTES = 147456;

#ifndef MK_N_LAUNCHES
#define MK_N_LAUNCHES 1
#endif
constexpr int N_PHASES = 7;
constexpr int N_LAUNCHES = MK_N_LAUNCHES;

struct Frame {
    LAS unsigned char* lds; volatile LAS unsigned* MISC; unsigned* ctl;
    int tid, lane, wave, vcu, G;
    const float *x, *c, *w_ada, *b_ada, *g_pre, *w_in, *g_q, *w_uq, *g_kv, *w_ukv, *w_out, *g_post; float* out;
    bf16 *WinT, *WoutT, *WuqT, *WukvT, *H, *Y, *AQ, *AK, *AV, *AZ, *BZ, *CQ, *CKV, *KPE, *Q, *KN, *V, *Y2;
    float *modp, *ssq_q, *ssq_kv, *ssq_y; f32x2* rope;
};
__device__ __forceinline__ float bf2f(bf16 u) { return __uint_as_float((unsigned)u << 16); }
__device__ __forceinline__ float wave_sum(float v) {
#pragma unroll
    for (int o = 1; o < 64; o <<= 1) v += __shfl_xor(v, o);
    return v;
}
__device__ __forceinline__ float wave_max(float v) {
#pragma unroll
    for (int o = 1; o < 64; o <<= 1) v = fmaxf(v, __shfl_xor(v, o));
    return v;
}

template <class Map>
__device__ __forceinline__ void p0_transpose_item(const float* W, int K, int N, bf16* WT, const float* g, LAS float* scr, int item, int nblk, int lane, Map map) {
    const int kb = item / nblk, nb = item % nblk, k0 = 64 * kb, n0 = 32 * nb;
    const int nsrc = map(n0 + (lane & 31));
#pragma unroll 8
    for (int i = 0; i < 32; ++i) { const int kk = 2 * i + (lane >> 5); float v = 0.f;
        if (nsrc >= 0) { v = W[(size_t)(k0 + kk) * N + nsrc]; if (g) v *= g[k0 + kk]; }
        scr[kk * 33 + (lane & 31)] = v; }
    LDS_WAIT(); asm volatile("" ::: "memory");
    const int c = lane & 7;
#pragma unroll
    for (int j = 0; j < 4; ++j) { const int n = (lane >> 3) + 8 * j; const LAS float* s = scr + (8 * c) * 33 + n;
        v4u o; o.x = pk2(s[0 * 33], s[1 * 33]); o.y = pk2(s[2 * 33], s[3 * 33]); o.z = pk2(s[4 * 33], s[5 * 33]); o.w = pk2(s[6 * 33], s[7 * 33]);
        *(v4u*)(WT + (size_t)(n0 + n) * K + k0 + 8 * c) = o; }
    LDS_WAIT(); asm volatile("" ::: "memory");
}
struct MapIn { __device__ __forceinline__ int operator()(int n) const {
    if (n < 4096) return n; if (n < 5120) return 4928 + (n - 4096); if (n < 5632) return 4096 + (n - 5120); if (n < 5888) return 4608 + (n - 5632);
    if (n < 5952) { const int i = n - 5888; return 4864 + (i >> 1) + 32 * (i & 1); } return -1; } };
struct MapUq { __device__ __forceinline__ int operator()(int n) const { const int hd = n / 192, w = n % 192; if (w < 128) return hd * 192 + w; const int i = w - 128; return hd * 192 + 128 + (i >> 1) + 32 * (i & 1); } };
struct MapUkv { __device__ __forceinline__ int operator()(int n) const { return n < 1024 ? (n >> 7) * 256 + (n & 127) : ((n - 1024) >> 7) * 256 + 128 + (n & 127); } };
struct MapId { __device__ __forceinline__ int operator()(int n) const { return n; } };

__device__ __forceinline__ void p0_prologue(Frame& F) {
    if (F.vcu < 192) {
        const int ct = F.vcu % 24, kc = F.vcu / 24, kbase = kc * 256 + F.wave * 32;
        const float* Wp = F.w_ada + (size_t)kbase * 6144 + ct * 256 + F.lane * 4;
        f32x4 acc[8];
#pragma unroll
        for (int b = 0; b < 8; ++b) acc[b] = (f32x4){0.f, 0.f, 0.f, 0.f};
        for (int k = 0; k < 32; ++k) { const f32x4 wv = *(const f32x4*)(Wp + (size_t)k * 6144);
#pragma unroll
            for (int b = 0; b < 8; ++b) { const float cv = F.c[b * DM + kbase + k]; const float s = cv / (1.0f + __expf(-cv)); acc[b] = acc[b] + wv * s; } }
        LAS float* red = (LAS float*)F.lds;
#pragma unroll
        for (int b = 0; b < 8; ++b) *(LAS f32x4*)(red + F.wave * 2048 + b * 256 + F.lane * 4) = acc[b];
        __syncthreads();
        f32x4 s = (f32x4){0.f, 0.f, 0.f, 0.f};
#pragma unroll
        for (int w = 0; w < 8; ++w) s = s + *(const LAS f32x4*)(red + w * 2048 + F.tid * 4);
        const int b = F.tid >> 6, cc = (F.tid & 63) * 4;
        if (kc == 0) s = s + *(const f32x4*)(F.b_ada + ct * 256 + cc);
        *(f32x4*)(F.modp + ((size_t)(kc * 8 + b) * 6144 + ct * 256 + cc)) = s;
        __syncthreads();
    }
    LAS float* scr = (LAS float*)(F.lds + RING_OFF + F.wave * 16384);
    const int gw = F.vcu * NWAVES + F.wave, NGW = F.G * NWAVES;
    constexpr int I_IN = (DM / 64) * (NIN / 32), I_OUT = (DM / 64) * (DM / 32), I_UQ = (QLORA / 64) * (1536 / 32), I_UKV = (KVLORA / 64) * (2048 / 32);
    constexpr int NITEMS = I_IN + I_OUT + I_UQ + I_UKV;
    for (int it = gw; it < NITEMS; it += NGW) {
        int r = it;
        if (r < I_IN) { p0_transpose_item(F.w_in, DM, DIN, F.WinT, (const float*)nullptr, scr, r, NIN / 32, F.lane, MapIn()); continue; } r -= I_IN;
        if (r < I_OUT) { p0_transpose_item(F.w_out, DM, DM, F.WoutT, (const float*)nullptr, scr, r, DM / 32, F.lane, MapId()); continue; } r -= I_OUT;
        if (r < I_UQ) { p0_transpose_item(F.w_uq, QLORA, 1536, F.WuqT, F.g_q, scr, r, 1536 / 32, F.lane, MapUq()); continue; } r -= I_UQ;
        p0_transpose_item(F.w_ukv, KVLORA, 2048, F.WukvT, F.g_kv, scr, r, 2048 / 32, F.lane, MapUkv());
    }
    for (int i = gw * 64 + F.lane; i < T * 32; i += NGW * 64) { const int t = i >> 5, j = i & 31;
        const float inv = exp2f(-(float)j * (13.287712379549449f / 32.0f)); const float ang = (float)t * inv;
        const double rev = (double)ang * 0.15915494309189535; const float fr = (float)(rev - floor(rev));
        F.rope[i] = (f32x2){__builtin_amdgcn_cosf(fr), __builtin_amdgcn_sinf(fr)}; }
}

__device__ __forceinline__ float modsum(const float* modp, int b, int col) { float s = 0.f;
#pragma unroll
    for (int kc = 0; kc < 8; ++kc) s += modp[(size_t)(kc * 8 + b) * 6144 + col];
    return s; }
__device__ __forceinline__ void p1_modulate(Frame& F) {
    const int rows_per = M / F.G, r0 = F.vcu * rows_per, b = r0 / T;
    LAS float* gs = (LAS float*)F.lds; LAS float* sh = gs + DM;
    for (int k = F.tid; k < DM; k += NWAVES * 64) { gs[k] = F.g_pre[k] * (1.0f + modsum(F.modp, b, DM + k)); sh[k] = modsum(F.modp, b, k); }
    __syncthreads();
    for (int r = r0 + F.wave; r < r0 + rows_per; r += NWAVES) {
        const f32x4* xr = (const f32x4*)(F.x + (size_t)r * DM) + F.lane; f32x4 v[8]; float s = 0.f;
#pragma unroll
        for (int j = 0; j < 8; ++j) { v[j] = xr[64 * j]; s += (v[j].x * v[j].x + v[j].y * v[j].y) + (v[j].z * v[j].z + v[j].w * v[j].w); }
        const float rstd = 1.0f / sqrtf(wave_sum(s) * (1.0f / DM) + EPS);
        unsigned long long* o8 = (unsigned long long*)(F.H + (size_t)r * DM) + F.lane;
#pragma unroll
        for (int j = 0; j < 8; ++j) { const f32x4 g4 = *(const LAS f32x4*)(gs + 4 * (F.lane + 64 * j)), s4 = *(const LAS f32x4*)(sh + 4 * (F.lane + 64 * j));
            const f32x4 hv = v[j] * rstd * g4 + s4;
            o8[64 * j] = (unsigned long long)pk2(hv.x, hv.y) | ((unsigned long long)pk2(hv.z, hv.w) << 32); }
    }
    __syncthreads();
}

__device__ __forceinline__ float dot8(const bf16* kp, const LAS float* q) {
    const bf16x8 kv = *(const bf16x8*)kp; const f32x4 q0 = *(const LAS f32x4*)q, q1 = *(const LAS f32x4*)(q + 4);
    return (bf2f((bf16)kv[0]) * q0[0] + bf2f((bf16)kv[1]) * q0[1]) + (bf2f((bf16)kv[2]) * q0[2] + bf2f((bf16)kv[3]) * q0[3])
         + (bf2f((bf16)kv[4]) * q1[0] + bf2f((bf16)kv[5]) * q1[1]) + (bf2f((bf16)kv[6]) * q1[2] + bf2f((bf16)kv[7]) * q1[3]);
}
__device__ __forceinline__ void naive_dilated(Frame& F) {
    LAS float* pb = (LAS float*)(F.lds + F.wave * 16384); LAS float* qs = pb + 640;
    const int gw = F.vcu * NWAVES + F.wave, NGW = F.G * NWAVES;
    for (int task = gw; task < M * AH; task += NGW) {
        const int m = task >> 3, h = task & 7, b = m >> 11, t = m & (T - 1);
        const bf16* q = F.AQ + (size_t)m * 1024 + h * 128;
        qs[F.lane] = bf2f(q[F.lane]); qs[F.lane + 64] = bf2f(q[F.lane + 64]);
        LDS_WAIT(); asm volatile("" ::: "memory");
        const float slope2 = exp2f(-(float)(h + 1)) * LOG2E;
        float lse[3];
#pragma unroll
        for (int p = 0; p < 3; ++p) { const int dil = p == 0 ? 1 : (p == 1 ? 4 : 16);
            float sv[3];
#pragma unroll
            for (int c = 0; c < 3; ++c) { const int idx = F.lane + 64 * c, j = idx - 64, tk = t + j * dil; float s = -1e30f;
                if (idx < 129 && tk >= 0 && tk < T) { const bf16* kr = F.AK + (size_t)(b * T + tk) * 1024 + h * 128; float a = 0.f;
                    for (int d8 = 0; d8 < 16; ++d8) a += dot8(kr + d8 * 8, qs + d8 * 8);
                    s = a - slope2 * (float)(dil * (j < 0 ? -j : j)); }
                sv[c] = s; }
            const float mx = wave_max(fmaxf(fmaxf(sv[0], sv[1]), sv[2]));
            float e[3]; float l = 0.f;
#pragma unroll
            for (int c = 0; c < 3; ++c) { e[c] = exp2f(sv[c] - mx); l += e[c]; }
            l = wave_sum(l);
#pragma unroll
            for (int c = 0; c < 3; ++c) pb[p * 192 + F.lane + 64 * c] = e[c] / l;
            lse[p] = mx + log2f(l); }
        LDS_WAIT(); asm volatile("" ::: "memory");
        const float ml = fmaxf(fmaxf(lse[0], lse[1]), lse[2]);
        float w[3]; float wsum = 0.f;
#pragma unroll
        for (int p = 0; p < 3; ++p) { w[p] = exp2f(lse[p] - ml); wsum += w[p]; }
#pragma unroll
        for (int dd = 0; dd < 2; ++dd) { const int d = F.lane + 64 * dd; float o = 0.f;
#pragma unroll
            for (int p = 0; p < 3; ++p) { const int dil = p == 0 ? 1 : (p == 1 ? 4 : 16); float op = 0.f;
                for (int idx = 0; idx < 129; ++idx) { const int tk = t + (idx - 64) * dil;
                    if (tk >= 0 && tk < T) op += pb[p * 192 + idx] * bf2f(F.AV[(size_t)(b * T + tk) * 1024 + h * 128 + d]); }
                o += (w[p] / wsum) * op; }
            const float y = o * bf2f(F.AZ[(size_t)m * 1024 + h * 128 + d]);
            F.Y[(size_t)m * 2048 + h * 128 + d] = (bf16)f2bf(y); }
        LDS_WAIT(); asm volatile("" ::: "memory");
    }
}
__device__ __forceinline__ void naive_mla(Frame& F) {
    LAS float* pb = (LAS float*)(F.lds + F.wave * 16384); LAS float* qs = pb + 2048;
    const int gw = F.vcu * NWAVES + F.wave, NGW = F.G * NWAVES;
    for (int task = gw; task < M * BH; task += NGW) {
        const int m = task >> 3, h = task & 7, b = m >> 11;
        const bf16* q = F.Q + (size_t)m * 1536 + h * 192;
        qs[F.lane] = bf2f(q[F.lane]); qs[F.lane + 64] = bf2f(q[F.lane + 64]); qs[F.lane + 128] = bf2f(q[F.lane + 128]);
        LDS_WAIT(); asm volatile("" ::: "memory");
        float mx = -1e30f;
        for (int i = 0; i < 32; ++i) { const int tk = F.lane + 64 * i; const bf16* kr = F.KN + (size_t)(b * T + tk) * 1024 + h * 128; const bf16* pr = F.KPE + (size_t)(b * T + tk) * 64; float a = 0.f;
            for (int d8 = 0; d8 < 16; ++d8) a += dot8(kr + d8 * 8, qs + d8 * 8);
            for (int d8 = 0; d8 < 8; ++d8) a += dot8(pr + d8 * 8, qs + 128 + d8 * 8);
            pb[tk] = a; mx = fmaxf(mx, a); }
        mx = wave_max(mx); float l = 0.f;
        for (int i = 0; i < 32; ++i) { const int tk = F.lane + 64 * i; const float e = exp2f(pb[tk] - mx); pb[tk] = e; l += e; }
        l = wave_sum(l); const float inv = 1.0f / l;
        LDS_WAIT(); asm volatile("" ::: "memory");
#pragma unroll
        for (int dd = 0; dd < 2; ++dd) { const int d = F.lane + 64 * dd; float o = 0.f; const bf16* vp = F.V + (size_t)(b * T) * 1024 + h * 128 + d;
            for (int tk = 0; tk < T; ++tk) o += pb[tk] * bf2f(vp[(size_t)tk * 1024]);
            const float y = o * inv * bf2f(F.BZ[(size_t)m * 1024 + h * 128 + d]);
            F.Y[(size_t)m * 2048 + 1024 + h * 128 + d] = (bf16)f2bf(y); }
        LDS_WAIT(); asm volatile("" ::: "memory");
    }
}

__device__ __forceinline__ void p6_final(Frame& F) {
    const int rows_per = M / F.G, r0 = F.vcu * rows_per, b = r0 / T;
    LAS float* gg = (LAS float*)F.lds;
    for (int k = F.tid; k < DM; k += NWAVES * 64) gg[k] = F.g_post[k] * modsum(F.modp, b, 2 * DM + k);
    __syncthreads();
    for (int r = r0 + F.wave; r < r0 + rows_per; r += NWAVES) {
        float s = F.lane < 32 ? F.ssq_y[(size_t)r * 32 + F.lane] : 0.f;
        const float rstd = 1.0f / sqrtf(wave_sum(s) * (1.0f / DM) + EPS);
        const f32x4* xr = (const f32x4*)(F.x + (size_t)r * DM) + F.lane; const unsigned long long* y8 = (const unsigned long long*)(F.Y2 + (size_t)r * DM) + F.lane;
        f32x4* orow = (f32x4*)(F.out + (size_t)r * DM) + F.lane;
#pragma unroll
        for (int j = 0; j < 8; ++j) { const f32x4 xv = xr[64 * j]; const unsigned long long yv = y8[64 * j]; const f32x4 g4 = *(const LAS f32x4*)(gg + 4 * (F.lane + 64 * j));
            f32x4 y; y.x = __uint_as_float((unsigned)(yv & 0xffffu) << 16); y.y = __uint_as_float((unsigned)(yv & 0xffff0000u)); y.z = __uint_as_float((unsigned)((yv >> 32) & 0xffffu) << 16); y.w = __uint_as_float((unsigned)((yv >> 32) & 0xffff0000u));
            orow[64 * j] = xv + g4 * (y * rstd); }
    }
    __syncthreads();
}

struct Args { const float* in[12]; float* out; unsigned char* ws; int ph_lo, ph_hi; };
__global__ void __launch_bounds__(NWAVES * 64, 2) mega_fwd(Args args) {
    extern __shared__ __attribute__((aligned(16))) unsigned char lds[];
    Frame F;
    F.lds = (LAS unsigned char*)lds; F.MISC = (volatile LAS unsigned*)(F.lds + MISC_OFF);
    F.tid = threadIdx.x; F.lane = F.tid & 63; F.wave = __builtin_amdgcn_readfirstlane(F.tid >> 6);
    F.G = gridDim.x; { const int bx = blockIdx.x; F.vcu = (F.G % 8 == 0) ? (bx % 8) * (F.G / 8) + bx / 8 : bx; }
    unsigned char* ws = args.ws;
    F.ctl = (unsigned*)(ws + WS_CTL);
    F.x = args.in[0]; F.c = args.in[1]; F.w_ada = args.in[2]; F.b_ada = args.in[3]; F.g_pre = args.in[4]; F.w_in = args.in[5]; F.g_q = args.in[6]; F.w_uq = args.in[7];
    F.g_kv = args.in[8]; F.w_ukv = args.in[9]; F.w_out = args.in[10]; F.g_post = args.in[11]; F.out = args.out;
    F.WinT = (bf16*)(ws + WS_WIN); F.WoutT = (bf16*)(ws + WS_WOUT); F.WuqT = (bf16*)(ws + WS_WUQ); F.WukvT = (bf16*)(ws + WS_WUKV);
    F.H = (bf16*)(ws + WS_H); F.Y = (bf16*)(ws + WS_Y); F.AQ = (bf16*)(ws + WS_AQ); F.AK = (bf16*)(ws + WS_AK); F.AV = (bf16*)(ws + WS_AV); F.AZ = (bf16*)(ws + WS_AZ); F.BZ = (bf16*)(ws + WS_BZ);
    F.CQ = (bf16*)(ws + WS_CQ); F.CKV = (bf16*)(ws + WS_CKV); F.KPE = (bf16*)(ws + WS_KPE); F.Q = (bf16*)(ws + WS_Q); F.KN = (bf16*)(ws + WS_KN); F.V = (bf16*)(ws + WS_V); F.Y2 = (bf16*)(ws + WS_Y2);
    F.modp = (float*)(ws + WS_MODP); F.ssq_q = (float*)(ws + WS_SSQQ); F.ssq_kv = (float*)(ws + WS_SSQKV); F.ssq_y = (float*)(ws + WS_SSQY); F.rope = (f32x2*)(ws + WS_ROPE);
    for (int u = F.tid; u < (LDS_BYTES - LDSCTL_OFF) / 4; u += NWAVES * 64) ((LAS unsigned*)(F.lds + LDSCTL_OFF))[u] = 0u;
    __syncthreads();
    XcdBarrier bar; bar.bar = F.ctl + CW_BAR; bar.x = 0; bar.st = nullptr;
    if (N_LAUNCHES == 1) bar = xcd_barrier_post(F.ctl + CW_BAR, F.MISC + 8);
    const int lo = args.ph_lo, hi = args.ph_hi;
#define IN(k) (lo <= (k) && (k) < hi)
#define SEAM(k) do { if (IN(k) && IN((k) + 1)) xcd_barrier(bar); } while (0)

    if (IN(0)) { p0_prologue(F); } SEAM(0);
    if (IN(1)) { p1_modulate(F); } SEAM(1);
    if (IN(2)) {
        pg8::Gemm g{F.H, F.WinT, M, NIN, DM}; pg8::StaticOrder S; S.init(M, NIN, F.G, (int)blockIdx.x);
        pg8::EpiProj E{F.AQ, F.AK, F.AV, F.AZ, F.BZ, F.CQ, F.CKV, F.KPE, F.ssq_q, F.ssq_kv, F.rope};
        pg8::gemm_phase<pg8::EpiProj, pg8::StaticOrder, true, true>(F.lds + RING_OFF, g, S, E);
    } SEAM(2);
    if (IN(3)) {
        { pg8::Gemm g{F.CQ, F.WuqT, M, 1536, QLORA}; pg8::StaticOrder S; S.init(M, 1536, F.G, (int)blockIdx.x);
          pg8::EpiUpQ E{F.Q, F.ssq_q, F.rope};
          pg8::gemm_phase<pg8::EpiUpQ, pg8::StaticOrder, true, true>(F.lds + RING_OFF, g, S, E); }
        { pg8::Gemm g{F.CKV, F.WukvT, M, 2048, KVLORA}; pg8::StaticOrder S; S.init(M, 2048, F.G, (int)blockIdx.x);
          pg8::EpiUpKV E{F.KN, F.V, F.ssq_kv};
          pg8::gemm_phase<pg8::EpiUpKV, pg8::StaticOrder, true, true>(F.lds + RING_OFF, g, S, E); }
        naive_dilated(F);
    } SEAM(3);
    if (IN(4)) { naive_mla(F); } SEAM(4);
    if (IN(5)) {
        pg8::Gemm g{F.Y, F.WoutT, M, DM, DM}; pg8::StaticOrder S; S.init(M, DM, F.G, (int)blockIdx.x);
        pg8::EpiOut E{F.Y2, F.ssq_y};
        pg8::gemm_phase<pg8::EpiOut, pg8::StaticOrder, true, true>(F.lds + RING_OFF, g, S, E);
    } SEAM(5);
    if (IN(6)) { p6_final(F); }
#undef IN
#undef SEAM
}

extern "C" void kernel_launch(void* const* d_in, const int* in_sizes, int n_in, void* d_out, int out_size, void* d_ws, size_t ws_size, hipStream_t stream) {
    static int grid = 0;
    if (grid == 0) {
        if (n_in != 12 || in_sizes[0] != M * DM || out_size != M * DM || ws_size < WS_END) { fprintf(stderr, "kernel_launch: unexpected shapes (n_in %d, in0 %d, out %d, ws %zu); nothing launched\n", n_in, n_in > 0 ? in_sizes[0] : -1, out_size, ws_size); grid = -1; return; }
        int dev = 0, cus = 0, per_cu = 0;
        if (hipGetDevice(&dev) != hipSuccess || hipDeviceGetAttribute(&cus, hipDeviceAttributeMultiprocessorCount, dev) != hipSuccess) { grid = -1; return; }
        if (hipFuncSetAttribute((const void*)mega_fwd, hipFuncAttributeMaxDynamicSharedMemorySize, LDS_BYTES) != hipSuccess) { fprintf(stderr, "kernel_launch: hipFuncSetAttribute failed\n"); grid = -1; return; }
        if (hipOccupancyMaxActiveBlocksPerMultiprocessor(&per_cu, (const void*)mega_fwd, NWAVES * 64, LDS_BYTES) != hipSuccess) per_cu = 0;
        (void)hipGetLastError();
        if (per_cu < 1 || cus * per_cu < 256) { fprintf(stderr, "kernel_launch: needs 256 co-resident workgroups, the device admits %d x %d; nothing launched\n", cus, per_cu); grid = -1; return; }
        grid = 256;
    }
    if (grid < 0) return;
    if (hipMemsetAsync((char*)d_ws + WS_CTL, 0, CTL_ZERO_BYTES, stream) != hipSuccess) return;
    Args a{};
    for (int i = 0; i < 12; ++i) a.in[i] = (const float*)d_in[i];
    a.out = (float*)d_out; a.ws = (unsigned char*)d_ws;
    if (N_LAUNCHES == 1) { a.ph_lo = 0; a.ph_hi = N_PHASES; hipLaunchKernelGGL(mega_fwd, dim3(grid), dim3(NWAVES * 64), LDS_BYTES, stream, a); }
    else for (int p = 0; p < N_PHASES; ++p) { a.ph_lo = p; a.ph_hi = p + 1; hipLaunchKernelGGL(mega_fwd, dim3(grid), dim3(NWAVES * 64), LDS_BYTES, stream, a); }
}
```

```cpp
#include <hip/hip_runtime.h>
#include <cstdio>
#include <cstdint>
namespace pg8 {
#define PG8_LAS __attribute__((address_space(3)))
typedef unsigned short bf16_t;
typedef short bf16x8 __attribute__((ext_vector_type(8)));
typedef float f32x4 __attribute__((ext_vector_type(4)));
typedef unsigned u32x4 __attribute__((ext_vector_type(4)));
constexpr int BM = 256, BK = 64, HALF = 128, HTB = HALF * BK * 2  , STAGE_BYTES = 8 * HTB, NXCD = 8, WGM = 8;

__host__ __device__ __forceinline__ int lds_byte(int r, int c) { const int st = (r >> 4) * 2 + (c >> 5), rr = r & 15, cc = c & 31, ob = rr * 64 + cc * 2; return st * 1024 + (ob ^ (((ob >> 9) & 1) << 5)); }
__host__ __device__ __forceinline__ void stage_rc(int b, int& R, int& C) { const int st = b / 1024, sb = b % 1024, swz = sb ^ (((sb >> 9) & 1) << 5); R = (st >> 1) * 16 + swz / 64; C = (st & 1) * 32 + (swz % 64) / 2; }
__host__ __device__ __forceinline__ int perm32(int rho) { const int n = rho >> 4, i = rho & 15; return 8 * (i >> 2) + 4 * n + (i & 3); }

struct Unit { int pm, pn; };
struct Gemm { const bf16_t* A; const bf16_t* Bt; int M, N, K; };

struct StaticOrder {
    int nM, nN, nwg, G, c;
    __host__ __device__ void init(int M, int N, int G_, int c_) { nM = M / BM; nN = N / BM; nwg = nM * nN; G = G_; c = c_; }
    __host__ __device__ bool next(int i, Unit& u) const {
        const long L = (long)i * G + c; if (L >= nwg) return false;
        int wgid = (int)L; { const int q = nwg / NXCD, r = nwg % NXCD, xcd = wgid % NXCD, off = wgid / NXCD; wgid = (xcd < r ? xcd * (q + 1) : r * (q + 1) + (xcd - r) * q) + off; }
        const int nig = WGM * nN, gid = wgid / nig, fm = gid * WGM, gsz = (nM - fm) < WGM ? (nM - fm) : WGM;
        u.pm = fm + ((wgid % nig) % gsz); u.pn = (wgid % nig) / gsz; return true;
    }
    __device__ __forceinline__ void a_ready(const Unit&) const {}
    __device__ __forceinline__ void done(const Unit&) const {}
};

__device__ __forceinline__ unsigned cvt_pk_bf16(float lo, float hi) { unsigned r; asm volatile("v_cvt_pk_bf16_f32 %0, %1, %2" : "=v"(r) : "v"(lo), "v"(hi)); return r; }
typedef float f32x2 __attribute__((ext_vector_type(2)));
__device__ __forceinline__ f32x2 gelu_pk(f32x2 v) {
    const f32x2 av = __builtin_elementwise_abs(v), d = av * 0.2316418882f + 1.0f;
    f32x2 t; t.x = __builtin_amdgcn_rcpf(d.x); t.y = __builtin_amdgcn_rcpf(d.y);
    f32x2 q = t * 0.5307027145f + (-0.7265760135f); q = q * t + 0.7107068705f; q = q * t + (-0.142248368f); q = q * t + 0.127414796f; q = q * t;
    const f32x2 s = (v * v) * (-0.72134752044f);
    f32x2 e; e.x = __builtin_amdgcn_exp2f(s.x); e.y = __builtin_amdgcn_exp2f(s.y);
    const f32x2 m = v * (q * e), r = v - m;
    f32x2 o; o.x = v.x < 0.f ? m.x : r.x; o.y = v.y < 0.f ? m.y : r.y; return o;
}

template <int ACT  > struct EpiBf16 {
    static constexpr bool PERM = true, AFTER_DRAIN = false; static_assert(ACT == 0 || ACT == 1, "EpiBf16: ACT is 0 (none) or 1 (gelu_pk)");
    bf16_t* O; int ldc; const float* bias; int split_cols; size_t split_stride; float scale0;
    __device__ __forceinline__ void operator()(const f32x4 (&acc)[2][2][4][2], const Unit& u, int wr, int wc, int fr, int fq) const {
        const int row0 = u.pm * BM + wr * 64 + fr; int colt = u.pn * BM; bf16_t* base = O;
        float sc = 1.f; if (split_cols) { const int t = colt / split_cols; base += (size_t)t * split_stride; colt -= t * split_cols; if (t == 0) sc = scale0; }
        const int col0 = colt + wc * 32 + 8 * fq, bcol0 = u.pn * BM + wc * 32 + 8 * fq;
        f32x4 bv[2][2];
#pragma unroll
        for (int bj = 0; bj < 2; ++bj)
#pragma unroll
            for (int n = 0; n < 2; ++n) bv[bj][n] = bias ? *(const f32x4*)(bias + bcol0 + bj * HALF + 4 * n) : (f32x4){0.f, 0.f, 0.f, 0.f};
#pragma unroll
        for (int ai = 0; ai < 2; ++ai)
#pragma unroll
            for (int m = 0; m < 4; ++m) { bf16_t* rowp = base + (size_t)(row0 + ai * HALF + m * 16) * ldc + col0;
#pragma unroll
                for (int bj = 0; bj < 2; ++bj) { f32x4 v0 = acc[ai][bj][m][0] + bv[bj][0], v1 = acc[ai][bj][m][1] + bv[bj][1];
                    if (ACT == 1) { f32x2 a = gelu_pk((f32x2){v0[0], v0[1]}), b = gelu_pk((f32x2){v0[2], v0[3]}), c = gelu_pk((f32x2){v1[0], v1[1]}), d = gelu_pk((f32x2){v1[2], v1[3]});
                        v0 = (f32x4){a.x, a.y, b.x, b.y}; v1 = (f32x4){c.x, c.y, d.x, d.y}; }
                    v0 = v0 * sc; v1 = v1 * sc; u32x4 w; w.x = cvt_pk_bf16(v0[0], v0[1]); w.y = cvt_pk_bf16(v0[2], v0[3]); w.z = cvt_pk_bf16(v1[0], v1[1]); w.w = cvt_pk_bf16(v1[2], v1[3]);
                    *(u32x4*)(rowp + bj * HALF) = w; } }
    }
};

struct PanelStats {
    unsigned* xbuf;
    unsigned* cnt;
    unsigned* tmo;
    int ntn; float eps;
    unsigned code;
    __device__ __forceinline__ bool run(const f32x4 (&v)[2][2][4][2], const Unit& u, int wr, int wc, int fr, int fq, PG8_LAS unsigned char* lds, int wid, int lane) const {
        typedef float f32x2v __attribute__((ext_vector_type(2)));
        PG8_LAS f32x2v* P = (PG8_LAS f32x2v*)lds;
        PG8_LAS f32x2v* S = (PG8_LAS f32x2v*)(lds + 8192);
        PG8_LAS unsigned* flag = (PG8_LAS unsigned*)(lds + 8192 + 2048);
#pragma unroll
        for (int ai = 0; ai < 2; ++ai)
#pragma unroll
            for (int m = 0; m < 4; ++m) {
                float s = 0.f;
#pragma unroll
                for (int bj = 0; bj < 2; ++bj)
#pragma unroll
                    for (int n = 0; n < 2; ++n) { const f32x4 x = v[ai][bj][m][n]; s += (x[0] + x[1]) + (x[2] + x[3]); }
                s += __shfl_xor(s, 16); s += __shfl_xor(s, 32);
                const float mw = s * (1.0f / 64.0f); float q = 0.f;
#pragma unroll
                for (int bj = 0; bj < 2; ++bj)
#pragma unroll
                    for (int n = 0; n < 2; ++n) { const f32x4 d = v[ai][bj][m][n] - mw; q += (d[0] * d[0] + d[1] * d[1]) + (d[2] * d[2] + d[3] * d[3]); }
                q += __shfl_xor(q, 16); q += __shfl_xor(q, 32);
                if (fq == 0) P[(ai * HALF + wr * 64 + m * 16 + fr) * 4 + wc] = (f32x2v){mw, q};
            }
        asm volatile("s_waitcnt lgkmcnt(0)" ::: "memory"); __builtin_amdgcn_s_barrier(); asm volatile("" ::: "memory");
#if defined(BROKEN_EXCHANGE_NO_WAIT)
#warning BROKEN CONTROL BUILD: the row-statistics exchange does not wait; results are wrong by design
        if (blockIdx.x >= 64) { const long long t0_ = clock64(); while (clock64() - t0_ < 60000) __builtin_amdgcn_s_sleep(8); }
#endif
        const int row = wid * 32 + (lane & 31);
        if (lane < 32) {
            const f32x2v a = P[row * 4 + 0], b = P[row * 4 + 1], c = P[row * 4 + 2], d = P[row * 4 + 3];
            const float mt = (a.x + b.x + c.x + d.x) * 0.25f;
            const float da = a.x - mt, db = b.x - mt, dc = c.x - mt, dd = d.x - mt;
            const float m2 = (a.y + b.y) + (c.y + d.y) + 64.0f * ((da * da + db * db) + (dc * dc + dd * dd));
            unsigned long long* slot = (unsigned long long*)xbuf + ((size_t)(u.pm * BM + row) * 4 + u.pn);
            __hip_atomic_store(slot, ((unsigned long long)__float_as_uint(m2) << 32) | __float_as_uint(mt), __ATOMIC_RELAXED, __HIP_MEMORY_SCOPE_AGENT);
        }
        asm volatile("s_waitcnt vmcnt(0)" ::: "memory");
        if (lane == 0) __hip_atomic_fetch_add(cnt + 64 * u.pm, 1u, __ATOMIC_RELAXED, __HIP_MEMORY_SCOPE_AGENT);
        if (wid == 0) {
            bool dead = false; const unsigned long long t0 = __builtin_amdgcn_s_memrealtime(); const unsigned want = 8u * (unsigned)ntn;
            for (;;) {
#if defined(BROKEN_EXCHANGE_NO_WAIT)
                break;
#endif
                if ((unsigned)__builtin_amdgcn_readfirstlane(__hip_atomic_load(cnt + 64 * u.pm, __ATOMIC_RELAXED, __HIP_MEMORY_SCOPE_AGENT)) >= want) break;
                if (__builtin_amdgcn_s_memrealtime() - t0 > 2000000ull) {
                    if (lane == 0) { unsigned expect = 0u; __hip_atomic_compare_exchange_strong(tmo + 1, &expect, code | (unsigned)(u.pm & 0xff), __ATOMIC_RELAXED, __ATOMIC_RELAXED, __HIP_MEMORY_SCOPE_AGENT);
                                     __hip_atomic_store(tmo, 1u, __ATOMIC_RELAXED, __HIP_MEMORY_SCOPE_AGENT); }
                    dead = true; break; }
                __builtin_amdgcn_s_sleep(2);
            }
            __builtin_amdgcn_fence(__ATOMIC_ACQUIRE, "agent");
            if (lane == 0) flag[0] = dead ? 1u : 0u;
        }
        asm volatile("s_waitcnt vmcnt(0) lgkmcnt(0)" ::: "memory"); __builtin_amdgcn_s_barrier(); asm volatile("" ::: "memory");
        const bool bad = flag[0] != 0u;
        if (lane < 32) {
            const unsigned long long* slot = (const unsigned long long*)xbuf + (size_t)(u.pm * BM + row) * 4; float mt[4], m2[4]; float ms = 0.f;
#pragma unroll
            for (int t = 0; t < 4; ++t) { if (t < ntn) { const unsigned long long w = __hip_atomic_load(slot + t, __ATOMIC_RELAXED, __HIP_MEMORY_SCOPE_AGENT); mt[t] = __uint_as_float((unsigned)w); m2[t] = __uint_as_float((unsigned)(w >> 32)); } else { mt[t] = 0.f; m2[t] = 0.f; } ms += mt[t]; }
            const float mean = ms / (float)ntn; float q = 0.f;
#pragma unroll
            for (int t = 0; t < 4; ++t) if (t < ntn) { const float dm = mt[t] - mean; q += m2[t] + 256.0f * dm * dm; }
            S[row] = (f32x2v){mean, 1.0f / sqrtf(q / (256.0f * (float)ntn) + eps)};
        }
        asm volatile("s_waitcnt lgkmcnt(0)" ::: "memory"); __builtin_amdgcn_s_barrier(); asm volatile("" ::: "memory");
        return bad;
    }
};
struct EpiLnRes {
    static constexpr bool PERM = false, AFTER_DRAIN = true;
    const float* base; float* out; int ldc; const float* bias; PanelStats st; unsigned poison;
    __device__ __forceinline__ void fused(f32x4 (&acc)[2][2][4][2], const Unit& u, int wr, int wc, int fr, int fq, PG8_LAS unsigned char* lds, int wid, int lane) const {
        typedef float f32x2v __attribute__((ext_vector_type(2)));
        const PG8_LAS f32x2v* S = (const PG8_LAS f32x2v*)(lds + 8192);
        const int col0 = u.pn * BM + wc * 32 + 4 * fq;
#pragma unroll
        for (int bj = 0; bj < 2; ++bj)
#pragma unroll
            for (int n = 0; n < 2; ++n) { const f32x4 bv = bias ? *(const f32x4*)(bias + col0 + bj * HALF + n * 16) : (f32x4){0.f, 0.f, 0.f, 0.f};
#pragma unroll
                for (int ai = 0; ai < 2; ++ai)
#pragma unroll
                    for (int m = 0; m < 4; ++m) acc[ai][bj][m][n] += bv; }
        f32x4 pre[4][2][2];
#pragma unroll
        for (int m = 0; m < 4; ++m) { const size_t off = (size_t)(u.pm * BM + wr * 64 + m * 16 + fr) * ldc + col0;
#pragma unroll
            for (int bj = 0; bj < 2; ++bj)
#pragma unroll
                for (int n = 0; n < 2; ++n) pre[m][bj][n] = *(const f32x4*)(base + off + bj * HALF + n * 16); }
        const bool bad = st.run(acc, u, wr, wc, fr, fq, lds, wid, lane) || poison != 0u;
        const float qnan = __builtin_nanf("");
#pragma unroll
        for (int ai = 0; ai < 2; ++ai)
#pragma unroll
            for (int m = 0; m < 4; ++m) { const int r = ai * HALF + wr * 64 + m * 16 + fr; const f32x2v sr = S[r]; const size_t off = (size_t)(u.pm * BM + r) * ldc + col0;
#pragma unroll
                for (int bj = 0; bj < 2; ++bj)
#pragma unroll
                    for (int n = 0; n < 2; ++n) { const f32x4 bs = ai == 0 ? pre[m][bj][n] : *(const f32x4*)(base + off + bj * HALF + n * 16); f32x4 o = bs + (acc[ai][bj][m][n] - sr.x) * sr.y;
                        if (bad) o = (f32x4){qnan, qnan, qnan, qnan}; *(f32x4*)(out + off + bj * HALF + n * 16) = o; }
                if (m & 1) asm volatile("" ::: "memory"); }
    }
};
struct EpiLnResLn {
    static constexpr bool PERM = false, AFTER_DRAIN = true;
    const float* base; float* out; bf16_t* xn; int ldc; const float* bias; PanelStats st1, st2; unsigned poison;
    __device__ __forceinline__ void fused(f32x4 (&acc)[2][2][4][2], const Unit& u, int wr, int wc, int fr, int fq, PG8_LAS unsigned char* lds, int wid, int lane) const {
        typedef float f32x2v __attribute__((ext_vector_type(2))); typedef unsigned u32x2v __attribute__((ext_vector_type(2)));
        const PG8_LAS f32x2v* S = (const PG8_LAS f32x2v*)(lds + 8192);
        const int col0 = u.pn * BM + wc * 32 + 4 * fq;
#pragma unroll
        for (int bj = 0; bj < 2; ++bj)
#pragma unroll
            for (int n = 0; n < 2; ++n) { const f32x4 bv = bias ? *(const f32x4*)(bias + col0 + bj * HALF + n * 16) : (f32x4){0.f, 0.f, 0.f, 0.f};
#pragma unroll
                for (int ai = 0; ai < 2; ++ai)
#pragma unroll
                    for (int m = 0; m < 4; ++m) acc[ai][bj][m][n] += bv; }
        bool bad = st1.run(acc, u, wr, wc, fr, fq, lds, wid, lane) || poison != 0u;
        const float qnan = __builtin_nanf("");
#pragma unroll
        for (int ai = 0; ai < 2; ++ai)
#pragma unroll
            for (int m = 0; m < 4; ++m) { const int r = ai * HALF + wr * 64 + m * 16 + fr; const f32x2v sr = S[r]; const size_t off = (size_t)(u.pm * BM + r) * ldc + col0;
#pragma unroll
                for (int bj = 0; bj < 2; ++bj)
#pragma unroll
                    for (int n = 0; n < 2; ++n) { const f32x4 bs = *(const f32x4*)(base + off + bj * HALF + n * 16); acc[ai][bj][m][n] = bs + (acc[ai][bj][m][n] - sr.x) * sr.y; }
                asm volatile("" : "+v"(acc[ai][0][m][0]), "+v"(acc[ai][0][m][1]), "+v"(acc[ai][1][m][0]), "+v"(acc[ai][1][m][1]));
                if (m & 1) asm volatile("" ::: "memory"); }
        const bool bad1 = bad;
        bad = st2.run(acc, u, wr, wc, fr, fq, lds, wid, lane) || bad;
#pragma unroll
        for (int ai = 0; ai < 2; ++ai)
#pragma unroll
            for (int m = 0; m < 4; ++m) { const int r = ai * HALF + wr * 64 + m * 16 + fr; const f32x2v sr = S[r]; const size_t off = (size_t)(u.pm * BM + r) * ldc + col0;
#pragma unroll
                for (int bj = 0; bj < 2; ++bj)
#pragma unroll
                    for (int n = 0; n < 2; ++n) { const f32x4 x1 = acc[ai][bj][m][n]; *(f32x4*)(out + off + bj * HALF + n * 16) = bad1 ? (f32x4){qnan, qnan, qnan, qnan} : x1;
                        const f32x4 o = (x1 - sr.x) * sr.y; u32x2v w; w.x = cvt_pk_bf16(o[0], o[1]); w.y = cvt_pk_bf16(o[2], o[3]);
                        if (bad) { w.x = 0x7fc07fc0u; w.y = 0x7fc07fc0u; } *(u32x2v*)(xn + off + bj * HALF + n * 16) = w; }
                asm volatile("" ::: "memory"); }
    }
};

template <class Epi, class Sched, bool ALIGN_EPI = false, bool SP2 = false>
__device__ __forceinline__ void gemm_phase(PG8_LAS unsigned char* lds, const Gemm g, const Sched& S, const Epi& E) {
    const int tid = threadIdx.x, wid = __builtin_amdgcn_readfirstlane(tid >> 6), lane = tid & 63, wr = wid >> 2, wc = wid & 3, fr = lane & 15, fq = lane >> 4;
    const int K = g.K, nt = K / BK;
    unsigned voffA[2], voffB[2];
#pragma unroll
    for (int i = 0; i < 2; ++i) { int R, C; stage_rc(tid * 16 + i * 8192, R, C); const int Rb = Epi::PERM ? ((R & ~31) + perm32(R & 31)) : R;
        voffA[i] = (unsigned)(R * K + C) * 2u; voffB[i] = (unsigned)(Rb * K + C) * 2u; }
    const size_t kstep = (size_t)(BK * 2);
    const size_t hstep = (size_t)HALF * K * 2;
    const size_t tstep = 2 * hstep;
    const unsigned ldsw = (unsigned)wid * 1024u;
    const int aoff = lds_byte(wr * 64 + fr, fq * 8), boff = lds_byte(wc * 32 + fr, fq * 8);
#define PG8_SA(b, h) (((b) * 2 + (h)) * HTB)
#define PG8_SB(b, h) ((4 + (b) * 2 + (h)) * HTB)
#define PG8_STAGE(bufoff, gbase, voff) do { _Pragma("unroll") for (int _i = 0; _i < 2; ++_i) \
        __builtin_amdgcn_global_load_lds((const unsigned*)((const char*)(gbase) + (voff)[_i]), (PG8_LAS unsigned*)(lds + (bufoff) + ldsw + _i * 8192), 16, 0, 0); } while (0)
#define PG8_LDA(dst, b, h) do { _Pragma("unroll") for (int m = 0; m < 4; ++m) _Pragma("unroll") for (int k = 0; k < 2; ++k) dst[m][k] = *(const PG8_LAS bf16x8*)(lds + PG8_SA(b, h) + aoff + m * 2048 + k * 1024); } while (0)
#define PG8_LDB(dst, b, h) do { _Pragma("unroll") for (int n = 0; n < 2; ++n) _Pragma("unroll") for (int k = 0; k < 2; ++k) dst[n][k] = *(const PG8_LAS bf16x8*)(lds + PG8_SB(b, h) + boff + n * 2048 + k * 1024); } while (0)
#define PG8_MMA(ai, bj, At, Bt) do { __builtin_amdgcn_s_setprio(1); _Pragma("unroll") for (int m = 0; m < 4; ++m) _Pragma("unroll") for (int n = 0; n < 2; ++n) _Pragma("unroll") for (int k = 0; k < 2; ++k) \
        acc[ai][bj][m][n] = __builtin_amdgcn_mfma_f32_16x16x32_bf16(Bt[n][k], At[m][k], acc[ai][bj][m][n], 0, 0, 0); __builtin_amdgcn_s_setprio(0); } while (0)
#define PG8_WAIT_V(n) asm volatile("s_waitcnt vmcnt(" #n ")" ::: "memory")
#define PG8_WAIT_L(n) asm volatile("s_waitcnt lgkmcnt(" #n ")" ::: "memory")
#define PG8_BAR __builtin_amdgcn_s_barrier()
#define PG8_SCHED __builtin_amdgcn_sched_barrier(0)
    Unit cur, nxt; int ui = 0;
    if (!S.next(0, cur)) return;
    f32x4 acc[2][2][4][2];
#pragma unroll
    for (int a = 0; a < 2; ++a)
#pragma unroll
        for (int b = 0; b < 2; ++b)
#pragma unroll
            for (int m = 0; m < 4; ++m)
#pragma unroll
                for (int n = 0; n < 2; ++n) acc[a][b][m][n] = (f32x4){0.f, 0.f, 0.f, 0.f};
    bf16x8 At[4][2], B0[2][2], B1[2][2];
    const char* cA = (const char*)g.A + (size_t)cur.pm * tstep; const char* cB = (const char*)g.Bt + (size_t)cur.pn * tstep;
    S.a_ready(cur);
    if constexpr (SP2) {
        PG8_STAGE(PG8_SB(0, 0), cB, voffB); PG8_STAGE(PG8_SB(0, 1), cB + hstep, voffB); PG8_STAGE(PG8_SA(0, 0), cA, voffA); PG8_STAGE(PG8_SA(0, 1), cA + hstep, voffA);
        if (wr == 1) PG8_BAR;
        PG8_WAIT_V(2); PG8_BAR;
        PG8_STAGE(PG8_SB(1, 0), cB + kstep, voffB); PG8_STAGE(PG8_SA(1, 0), cA + kstep, voffA); PG8_STAGE(PG8_SB(1, 1), cB + hstep + kstep, voffB);
        PG8_WAIT_V(6); PG8_BAR;
    } else {
        PG8_STAGE(PG8_SB(0, 0), cB, voffB); PG8_STAGE(PG8_SA(0, 0), cA, voffA); PG8_STAGE(PG8_SB(0, 1), cB + hstep, voffB); PG8_STAGE(PG8_SA(0, 1), cA + hstep, voffA);
        if (wr == 1) PG8_BAR;
        PG8_WAIT_V(4); PG8_BAR;
        PG8_STAGE(PG8_SB(1, 0), cB + kstep, voffB); PG8_STAGE(PG8_SA(1, 0), cA + kstep, voffA); PG8_STAGE(PG8_SB(1, 1), cB + hstep + kstep, voffB);
        PG8_WAIT_V(6); PG8_BAR;
    }
    for (;;) {
        const bool has_next = S.next(ui + 1, nxt);
        const char* nA = has_next ? (const char*)g.A + (size_t)nxt.pm * tstep : cA; const char* nB = has_next ? (const char*)g.Bt + (size_t)nxt.pn * tstep : cB;
        for (int t = 0; t < nt; t += 2) {
            const bool last = (t == nt - 2);
            const char* a1 = cA + (size_t)(t + 1) * kstep;
            const char* a2 = last ? nA : cA + (size_t)(t + 2) * kstep; const char* b2 = last ? nB : cB + (size_t)(t + 2) * kstep;
            const char* a3 = a2 + kstep; const char* b3 = b2 + kstep;
            if (last && has_next) S.a_ready(nxt);
            if constexpr (SP2) {
            PG8_LDB(B0, 0, 0); PG8_LDB(B1, 0, 1); PG8_SCHED; PG8_LDA(At, 0, 0); PG8_STAGE(PG8_SA(1, 1), a1 + hstep, voffA);
            PG8_WAIT_V(8); PG8_WAIT_L(0); PG8_BAR; PG8_MMA(0, 0, At, B0); PG8_MMA(0, 1, At, B1); PG8_BAR; PG8_SCHED;
            PG8_LDA(At, 0, 1); PG8_STAGE(PG8_SB(0, 0), b2, voffB); PG8_STAGE(PG8_SB(0, 1), b2 + hstep, voffB); PG8_STAGE(PG8_SA(0, 0), a2, voffA);
            PG8_WAIT_V(8); PG8_WAIT_L(0); PG8_BAR; PG8_MMA(1, 0, At, B0); PG8_MMA(1, 1, At, B1); PG8_BAR; PG8_SCHED;
            PG8_LDB(B0, 1, 0); PG8_LDB(B1, 1, 1); PG8_SCHED; PG8_LDA(At, 1, 0); PG8_STAGE(PG8_SA(0, 1), a2 + hstep, voffA);
            PG8_WAIT_V(8); PG8_WAIT_L(0); PG8_BAR; PG8_MMA(0, 0, At, B0); PG8_MMA(0, 1, At, B1); PG8_BAR; PG8_SCHED;
            PG8_LDA(At, 1, 1); PG8_STAGE(PG8_SB(1, 0), b3, voffB); PG8_STAGE(PG8_SB(1, 1), b3 + hstep, voffB); PG8_STAGE(PG8_SA(1, 0), a3, voffA);
            PG8_WAIT_V(8); PG8_WAIT_L(0); PG8_BAR; PG8_MMA(1, 0, At, B0); PG8_MMA(1, 1, At, B1); PG8_BAR; PG8_SCHED;
            } else {
            PG8_LDB(B0, 0, 0); PG8_SCHED; PG8_LDA(At, 0, 0); PG8_STAGE(PG8_SA(1, 1), a1 + hstep, voffA);
            PG8_WAIT_L(8); PG8_BAR; PG8_WAIT_L(0); PG8_MMA(0, 0, At, B0); PG8_BAR; PG8_SCHED;
            PG8_LDB(B1, 0, 1); PG8_STAGE(PG8_SB(0, 0), b2, voffB);
            PG8_BAR; PG8_WAIT_L(0); PG8_MMA(0, 1, At, B1); PG8_BAR;
            PG8_LDA(At, 0, 1); PG8_STAGE(PG8_SA(0, 0), a2, voffA);
            PG8_BAR; PG8_WAIT_L(0); PG8_MMA(1, 0, At, B0); PG8_BAR; PG8_SCHED;
            PG8_STAGE(PG8_SB(0, 1), b2 + hstep, voffB);
            PG8_WAIT_V(6); PG8_BAR; PG8_MMA(1, 1, At, B1); PG8_BAR;
            PG8_LDB(B0, 1, 0); PG8_SCHED; PG8_LDA(At, 1, 0); PG8_STAGE(PG8_SA(0, 1), a2 + hstep, voffA);
            PG8_WAIT_L(8); PG8_BAR; PG8_WAIT_L(0); PG8_MMA(0, 0, At, B0); PG8_BAR; PG8_SCHED;
            PG8_LDB(B1, 1, 1); PG8_STAGE(PG8_SB(1, 0), b3, voffB);
            PG8_BAR; PG8_WAIT_L(0); PG8_MMA(0, 1, At, B1); PG8_BAR;
            PG8_LDA(At, 1, 1); PG8_STAGE(PG8_SA(1, 0), a3, voffA);
            PG8_BAR; PG8_WAIT_L(0); PG8_MMA(1, 0, At, B0); PG8_BAR; PG8_SCHED;
            PG8_STAGE(PG8_SB(1, 1), b3 + hstep, voffB);
            PG8_WAIT_V(6); PG8_BAR; PG8_MMA(1, 1, At, B1); PG8_BAR;
            }
        }
        if constexpr (ALIGN_EPI) { if (wr == 0) PG8_BAR; }
        if constexpr (!Epi::AFTER_DRAIN) { E(acc, cur, wr, wc, fr, fq); S.done(cur); }
        if (!has_next) break;
#pragma unroll
        for (int a = 0; a < 2; ++a)
#pragma unroll
            for (int b = 0; b < 2; ++b)
#pragma unroll
                for (int m = 0; m < 4; ++m)
#pragma unroll
                    for (int n = 0; n < 2; ++n) acc[a][b][m][n] = (f32x4){0.f, 0.f, 0.f, 0.f};
        cur = nxt; cA = nA; cB = nB; ++ui;
        if constexpr (ALIGN_EPI) { if (wr == 1) PG8_BAR; }
    }
    PG8_WAIT_V(0);
    if constexpr (!ALIGN_EPI) { if (wr == 0) PG8_BAR; }
    PG8_BAR;
    if constexpr (Epi::AFTER_DRAIN) { E.fused(acc, cur, wr, wc, fr, fq, lds, wid, lane); S.done(cur); }
#undef PG8_SA
#undef PG8_SB
#undef PG8_STAGE
#undef PG8_LDA
#undef PG8_LDB
#undef PG8_MMA
#undef PG8_WAIT_V
#undef PG8_WAIT_L
#undef PG8_BAR
#undef PG8_SCHED
}
}
constexpr int NWAVES = 8;
constexpr int BATCH = 8, T = 2048, DM = 2048, M = BATCH * T;
constexpr int AH = 8, BH = 8, QLORA = 512, KVLORA = 256;
constexpr int DIN = 5952, NIN = 6144;
constexpr float EPS = 1e-6f;
constexpr float LOG2E = 1.4426950408889634f;
constexpr float ASCALE = 0.08838834764831845f * LOG2E;
constexpr float BSCALE = 0.07216878364870323f * LOG2E;
typedef float f32x2 __attribute__((ext_vector_type(2)));

namespace pg8 {
__device__ __forceinline__ float silu_f(float v) { return v * __builtin_amdgcn_rcpf(1.0f + __builtin_amdgcn_exp2f(-v * 1.4426950408889634f)); }
__device__ __forceinline__ u32x4 pack8(const f32x4& v0, const f32x4& v1) { u32x4 w; w.x = cvt_pk_bf16(v0[0], v0[1]); w.y = cvt_pk_bf16(v0[2], v0[3]); w.z = cvt_pk_bf16(v1[0], v1[1]); w.w = cvt_pk_bf16(v1[2], v1[3]); return w; }
__device__ __forceinline__ void rope8(f32x4& v0, f32x4& v1, const f32x2* rope, int t, int j0) {
    const f32x4 c01 = *(const f32x4*)(rope + t * 32 + j0), c23 = *(const f32x4*)(rope + t * 32 + j0 + 2);
    f32x4 o0, o1;
    o0[0] = v0[0] * c01[0] - v0[1] * c01[1]; o0[1] = v0[0] * c01[1] + v0[1] * c01[0];
    o0[2] = v0[2] * c01[2] - v0[3] * c01[3]; o0[3] = v0[2] * c01[3] + v0[3] * c01[2];
    o1[0] = v1[0] * c23[0] - v1[1] * c23[1]; o1[1] = v1[0] * c23[1] + v1[1] * c23[0];
    o1[2] = v1[2] * c23[2] - v1[3] * c23[3]; o1[3] = v1[2] * c23[3] + v1[3] * c23[2];
    v0 = o0; v1 = o1;
}
struct EpiProj {
    static constexpr bool PERM = true, AFTER_DRAIN = false;
    bf16_t *AQ, *AK, *AV, *AZ, *BZ, *CQ, *CKV, *KPE; float *ssq_q, *ssq_kv; const f32x2* rope;
    __device__ __forceinline__ void operator()(const f32x4 (&acc)[2][2][4][2], const Unit& u, int wr, int wc, int fr, int fq) const {
        const int pn = u.pn, row0 = u.pm * BM + wr * 64 + fr, cl0 = wc * 32 + 8 * fq;
        if (pn < 20) {
            bf16_t* base; int ct; float sc = 1.f; bool act = false;
            if (pn < 4) { base = AQ; ct = pn; sc = ASCALE; } else if (pn < 8) { base = AK; ct = pn - 4; } else if (pn < 12) { base = AV; ct = pn - 8; }
            else if (pn < 16) { base = AZ; ct = pn - 12; act = true; } else { base = BZ; ct = pn - 16; act = true; }
#pragma unroll
            for (int ai = 0; ai < 2; ++ai)
#pragma unroll
                for (int m = 0; m < 4; ++m) { bf16_t* rowp = base + (size_t)(row0 + ai * HALF + m * 16) * 1024 + ct * 256 + cl0;
#pragma unroll
                    for (int bj = 0; bj < 2; ++bj) { f32x4 v0 = acc[ai][bj][m][0], v1 = acc[ai][bj][m][1];
                        if (act) {
#pragma unroll
                            for (int e = 0; e < 4; ++e) { v0[e] = silu_f(v0[e]); v1[e] = silu_f(v1[e]); } }
                        else { v0 = v0 * sc; v1 = v1 * sc; }
                        *(u32x4*)(rowp + bj * HALF) = pack8(v0, v1); } }
        } else if (pn < 23) {
            bf16_t* base; int ld, ct, ns; float* ssq;
            if (pn < 22) { base = CQ; ld = 512; ct = pn - 20; ssq = ssq_q; ns = 8; } else { base = CKV; ld = 256; ct = 0; ssq = ssq_kv; ns = 4; }
#pragma unroll
            for (int ai = 0; ai < 2; ++ai)
#pragma unroll
                for (int m = 0; m < 4; ++m) { const int row = row0 + ai * HALF + m * 16; bf16_t* rowp = base + (size_t)row * ld + ct * 256 + cl0; float s = 0.f;
#pragma unroll
                    for (int bj = 0; bj < 2; ++bj) { const f32x4 v0 = acc[ai][bj][m][0], v1 = acc[ai][bj][m][1];
                        s += (v0[0] * v0[0] + v0[1] * v0[1]) + (v0[2] * v0[2] + v0[3] * v0[3]) + (v1[0] * v1[0] + v1[1] * v1[1]) + (v1[2] * v1[2] + v1[3] * v1[3]);
                        *(u32x4*)(rowp + bj * HALF) = pack8(v0, v1); }
                    s += __shfl_xor(s, 16); s += __shfl_xor(s, 32);
                    if (fq == 0) ssq[(size_t)row * ns + ct * 4 + wc] = s; }
        } else {
            if (wc < 2) {
#pragma unroll
                for (int ai = 0; ai < 2; ++ai)
#pragma unroll
                    for (int m = 0; m < 4; ++m) { const int row = row0 + ai * HALF + m * 16; f32x4 v0 = acc[ai][0][m][0], v1 = acc[ai][0][m][1];
                        rope8(v0, v1, rope, row & (T - 1), cl0 >> 1);
                        *(u32x4*)(KPE + (size_t)row * 64 + cl0) = pack8(v0, v1); }
            }
        }
    }
};
struct EpiUpQ {
    static constexpr bool PERM = true, AFTER_DRAIN = false;
    bf16_t* Q; const float* ssq; const f32x2* rope;
    __device__ __forceinline__ void operator()(const f32x4 (&acc)[2][2][4][2], const Unit& u, int wr, int wc, int fr, int fq) const {
        const int row0 = u.pm * BM + wr * 64 + fr, c0 = u.pn * BM + wc * 32 + 8 * fq;
#pragma unroll
        for (int ai = 0; ai < 2; ++ai)
#pragma unroll
            for (int m = 0; m < 4; ++m) { const int row = row0 + ai * HALF + m * 16;
                const f32x4 sa = *(const f32x4*)(ssq + (size_t)row * 8), sb = *(const f32x4*)(ssq + (size_t)row * 8 + 4);
                const float ss = ((sa[0] + sa[1]) + (sa[2] + sa[3])) + ((sb[0] + sb[1]) + (sb[2] + sb[3]));
                const float rs = BSCALE / sqrtf(ss * (1.0f / 512.0f) + EPS);
#pragma unroll
                for (int bj = 0; bj < 2; ++bj) { const int c = c0 + bj * HALF, w = c % 192; f32x4 v0 = acc[ai][bj][m][0] * rs, v1 = acc[ai][bj][m][1] * rs;
                    if (w >= 128) rope8(v0, v1, rope, row & (T - 1), (w - 128) >> 1);
                    *(u32x4*)(Q + (size_t)row * 1536 + c) = pack8(v0, v1); } }
    }
};
struct EpiUpKV {
    static constexpr bool PERM = true, AFTER_DRAIN = false;
    bf16_t *KN, *V; const float* ssq;
    __device__ __forceinline__ void operator()(const f32x4 (&acc)[2][2][4][2], const Unit& u, int wr, int wc, int fr, int fq) const {
        const int row0 = u.pm * BM + wr * 64 + fr, cl0 = wc * 32 + 8 * fq; bf16_t* base = u.pn < 4 ? KN : V; const int ct = u.pn & 3;
#pragma unroll
        for (int ai = 0; ai < 2; ++ai)
#pragma unroll
            for (int m = 0; m < 4; ++m) { const int row = row0 + ai * HALF + m * 16;
                const f32x4 sa = *(const f32x4*)(ssq + (size_t)row * 4);
                const float rs = 1.0f / sqrtf(((sa[0] + sa[1]) + (sa[2] + sa[3])) * (1.0f / 256.0f) + EPS);
#pragma unroll
                for (int bj = 0; bj < 2; ++bj) { const f32x4 v0 = acc[ai][bj][m][0] * rs, v1 = acc[ai][bj][m][1] * rs;
                    *(u32x4*)(base + (size_t)row * 1024 + ct * 256 + bj * HALF + cl0) = pack8(v0, v1); } }
    }
};
struct EpiOut {
    static constexpr bool PERM = true, AFTER_DRAIN = false;
    bf16_t* Y2; float* ssq;
    __device__ __forceinline__ void operator()(const f32x4 (&acc)[2][2][4][2], const Unit& u, int wr, int wc, int fr, int fq) const {
        const int row0 = u.pm * BM + wr * 64 + fr, cl0 = wc * 32 + 8 * fq;
#pragma unroll
        for (int ai = 0; ai < 2; ++ai)
#pragma unroll
            for (int m = 0; m < 4; ++m) { const int row = row0 + ai * HALF + m * 16; bf16_t* rowp = Y2 + (size_t)row * 2048 + u.pn * 256 + cl0; float s = 0.f;
#pragma unroll
                for (int bj = 0; bj < 2; ++bj) { const f32x4 v0 = acc[ai][bj][m][0], v1 = acc[ai][bj][m][1];
                    s += (v0[0] * v0[0] + v0[1] * v0[1]) + (v0[2] * v0[2] + v0[3] * v0[3]) + (v1[0] * v1[0] + v1[1] * v1[1]) + (v1[2] * v1[2] + v1[3] * v1[3]);
                    *(u32x4*)(rowp + bj * HALF) = pack8(v0, v1); }
                s += __shfl_xor(s, 16); s += __shfl_xor(s, 32);
                if (fq == 0) ssq[(size_t)row * 32 + u.pn * 4 + wc] = s; }
    }
};
}
#define GAS __attribute__((address_space(1)))
#define LAS __attribute__((address_space(3)))
typedef unsigned short bf16;
typedef unsigned v4u __attribute__((ext_vector_type(4)));
typedef float f32x4 __attribute__((ext_vector_type(4)));
typedef short bf16x8 __attribute__((ext_vector_type(8)));
typedef GAS unsigned gu32;
typedef GAS unsigned long long gu64;
#define RLX_AGENT __ATOMIC_RELAXED, __HIP_MEMORY_SCOPE_AGENT
#define LDS_WAIT() asm volatile("s_waitcnt lgkmcnt(0)" ::: "memory")
#define VM_WAIT() asm volatile("s_waitcnt vmcnt(0)" ::: "memory")
__device__ __forceinline__ unsigned long long rt() { return __builtin_amdgcn_s_memrealtime(); }
__device__ __forceinline__ unsigned f2bf(float f) { unsigned u = __builtin_bit_cast(unsigned, f); return (u + 0x7fffu + ((u >> 16) & 1u)) >> 16; }
__device__ __forceinline__ unsigned pk2(float lo, float hi) { return f2bf(lo) | (f2bf(hi) << 16); }

#define XB_TMO      128
#define XB_XCNT(j)  (256  + 64 * (j))
#define XB_XSUB(j)  (1280 + 64 * (j))
#define XB_XGEN(j)  (2304 + 64 * (j))
#define XB_TOP      3328
#define XB_TOPGEN   3392
#define XCD_BAR_WORDS 3456
#define XB_SPIN_CAP (1u << 21)

__device__ __forceinline__ unsigned xb_ld(unsigned* p)              { return __hip_atomic_load(p, __ATOMIC_RELAXED, __HIP_MEMORY_SCOPE_AGENT); }
__device__ __forceinline__ unsigned xb_add(unsigned* p, unsigned v) { return __hip_atomic_fetch_add(p, v, __ATOMIC_RELAXED, __HIP_MEMORY_SCOPE_AGENT); }
__device__ __forceinline__ unsigned xb_xcc_id() { return (unsigned)__builtin_amdgcn_s_getreg((3 << 11) | 20) & 0xFu; }
#define XB_SPIN(cond, bar) do { unsigned _sp = 0; while (cond) { __builtin_amdgcn_s_sleep(1); \
    if ((++_sp & 255u) == 0u) { if (xb_ld(&(bar)[XB_TMO])) break; if (_sp > XB_SPIN_CAP) { atomicAdd(&(bar)[XB_TMO], 1u); break; } } } } while (0)

struct XcdBarrier {
    unsigned* bar; unsigned x;
    volatile LAS unsigned* st;
};

__device__ __forceinline__ XcdBarrier xcd_barrier_post(unsigned* bar, volatile LAS unsigned* st) {
    XcdBarrier b; b.bar = bar; b.x = xb_xcc_id(); b.st = st;
    if (threadIdx.x == 0) (void)xb_add(&bar[XB_XCNT(b.x)], 1u);
    return b;
}
__device__ __forceinline__ void xcd_barrier_complete(unsigned* bar, unsigned x, unsigned& nloc, unsigned& nx) {
    const unsigned G = gridDim.x * gridDim.y * gridDim.z;
    unsigned sum, cnt, mine, sp = 0u;
    for (;;) {
        sum = 0u; cnt = 0u; mine = 0u;
#pragma unroll
        for (unsigned j = 0; j < 16; ++j) { const unsigned c = xb_ld(&bar[XB_XCNT(j)]); sum += c; cnt += (c > 0u) ? 1u : 0u; mine = (j == x) ? c : mine; }
        if (sum == G) break;
        __builtin_amdgcn_s_sleep(1);
        if ((++sp & 255u) == 0u) { if (xb_ld(&bar[XB_TMO])) break; if (sp > XB_SPIN_CAP) { atomicAdd(&bar[XB_TMO], 1u); break; } }
    }
    nloc = mine > 0u ? mine : 1u; nx = cnt > 0u ? cnt : 1u;
}

__device__ __forceinline__ void xcd_barrier(const XcdBarrier& b) {
    asm volatile("s_waitcnt vmcnt(0)" ::: "memory");
    __syncthreads();
    if (threadIdx.x == 0) {
        unsigned* bar = b.bar;
        __builtin_amdgcn_s_waitcnt(0);
        unsigned nloc = b.st[0], nx = b.st[1];
        if (nloc == 0u) { xcd_barrier_complete(bar, b.x, nloc, nx); b.st[0] = nloc; b.st[1] = nx; }
        const unsigned old = xb_add(&bar[XB_XSUB(b.x)], 1u);
        const unsigned gen = old / nloc;
        if (old + 1u == (gen + 1u) * nloc) {
            __builtin_amdgcn_fence(__ATOMIC_RELEASE, "agent");
            asm volatile("s_waitcnt vmcnt(0)" ::: "memory");
            const unsigned og = xb_add(&bar[XB_TOP], 1u);
            const unsigned tg = og / nx;
            if (og + 1u == (tg + 1u) * nx) xb_add(&bar[XB_TOPGEN], 1u);
            else XB_SPIN(xb_ld(&bar[XB_TOPGEN]) == tg, bar);
            __builtin_amdgcn_fence(__ATOMIC_ACQUIRE, "agent");
            xb_add(&bar[XB_XGEN(b.x)], 1u);
            asm volatile("s_waitcnt vmcnt(0)" ::: "memory");
        } else {
            XB_SPIN(xb_ld(&bar[XB_XGEN(b.x)]) == gen, bar);
            __builtin_amdgcn_fence(__ATOMIC_ACQUIRE, "agent");
            asm volatile("s_waitcnt vmcnt(0)" ::: "memory");
        }
    }
    __syncthreads();
}
constexpr size_t MiB = 1u << 20;
constexpr size_t WS_CTL = 0, CTL_ZERO_BYTES = 1 * MiB;
constexpr size_t WS_ROPE = 1 * MiB;
constexpr size_t WS_MODP = 2 * MiB;
constexpr size_t WS_WIN = 4 * MiB, WS_WOUT = 28 * MiB, WS_WUQ = 36 * MiB, WS_WUKV = 38 * MiB;
constexpr size_t WS_H = 40 * MiB;
constexpr size_t WS_OP0 = 40 * MiB, WS_OP1 = 72 * MiB, WS_OP2 = 402 * MiB, WS_LSEP = 434 * MiB;
constexpr size_t WS_Y2 = 40 * MiB;
constexpr size_t WS_AQ = 104 * MiB, WS_AK = 136 * MiB, WS_AV = 168 * MiB, WS_AZ = 200 * MiB, WS_BZ = 232 * MiB;
constexpr size_t WS_Y = 104 * MiB;
constexpr size_t WS_CQ = 264 * MiB, WS_CKV = 280 * MiB, WS_KPE = 288 * MiB;
constexpr size_t WS_Q = 290 * MiB, WS_KN = 338 * MiB, WS_V = 370 * MiB;
constexpr size_t WS_SSQQ = 466 * MiB, WS_SSQKV = 467 * MiB, WS_SSQY = 468 * MiB, WS_END = 470 * MiB;
constexpr int CW_BAR = 4096;

constexpr int RING_OFF = 0, RING_BYTES = 131072;
constexpr int LDSCTL_OFF = RING_BYTES, MISC_OFF = LDSCTL_OFF + 320;
constexpr int LDS_BYTES = 147456;

#ifndef MK_N_LAUNCHES
#define MK_N_LAUNCHES 1
#endif
constexpr int N_PHASES = 7;
constexpr int N_LAUNCHES = MK_N_LAUNCHES;

struct Frame {
    LAS unsigned char* lds; volatile LAS unsigned* MISC; unsigned* ctl;
    int tid, lane, wave, vcu, G;
    const float *x, *c, *w_ada, *b_ada, *g_pre, *w_in, *g_q, *w_uq, *g_kv, *w_ukv, *w_out, *g_post; float* out;
    bf16 *WinT, *WoutT, *WuqT, *WukvT, *H, *Y, *AQ, *AK, *AV, *AZ, *BZ, *CQ, *CKV, *KPE, *Q, *KN, *V, *Y2;
    float *modp, *ssq_q, *ssq_kv, *ssq_y, *LSEP; f32x2* rope; bf16 *OP0, *OP1, *OP2; unsigned char* wsb;
};
__device__ __forceinline__ float bf2f(bf16 u) { return __uint_as_float((unsigned)u << 16); }
__device__ __forceinline__ float wave_sum(float v) {
#pragma unroll
    for (int o = 1; o < 64; o <<= 1) v += __shfl_xor(v, o);
    return v;
}
__device__ __forceinline__ float wave_max(float v) {
#pragma unroll
    for (int o = 1; o < 64; o <<= 1) v = fmaxf(v, __shfl_xor(v, o));
    return v;
}

template <class Map>
__device__ __forceinline__ void p0_transpose_item(const float* W, int K, int N, bf16* WT, const float* g, LAS float* scr, int item, int nblk, int lane, Map map) {
    const int kb = item / nblk, nb = item % nblk, k0 = 64 * kb, n0 = 32 * nb;
    const int nsrc = map(n0 + (lane & 31));
#pragma unroll 8
    for (int i = 0; i < 32; ++i) { const int kk = 2 * i + (lane >> 5); float v = 0.f;
        if (nsrc >= 0) { v = W[(size_t)(k0 + kk) * N + nsrc]; if (g) v *= g[k0 + kk]; }
        scr[kk * 33 + (lane & 31)] = v; }
    LDS_WAIT(); asm volatile("" ::: "memory");
    const int c = lane & 7;
#pragma unroll
    for (int j = 0; j < 4; ++j) { const int n = (lane >> 3) + 8 * j; const LAS float* s = scr + (8 * c) * 33 + n;
        v4u o; o.x = pk2(s[0 * 33], s[1 * 33]); o.y = pk2(s[2 * 33], s[3 * 33]); o.z = pk2(s[4 * 33], s[5 * 33]); o.w = pk2(s[6 * 33], s[7 * 33]);
        *(v4u*)(WT + (size_t)(n0 + n) * K + k0 + 8 * c) = o; }
    LDS_WAIT(); asm volatile("" ::: "memory");
}
struct MapIn { __device__ __forceinline__ int operator()(int n) const {
    if (n < 4096) return n; if (n < 5120) return 4928 + (n - 4096); if (n < 5632) return 4096 + (n - 5120); if (n < 5888) return 4608 + (n - 5632);
    if (n < 5952) { const int i = n - 5888; return 4864 + (i >> 1) + 32 * (i & 1); } return -1; } };
struct MapUq { __device__ __forceinline__ int operator()(int n) const { const int hd = n / 192, w = n % 192; if (w < 128) return hd * 192 + w; const int i = w - 128; return hd * 192 + 128 + (i >> 1) + 32 * (i & 1); } };
struct MapUkv { __device__ __forceinline__ int operator()(int n) const { return n < 1024 ? (n >> 7) * 256 + (n & 127) : ((n - 1024) >> 7) * 256 + 128 + (n & 127); } };
struct MapId { __device__ __forceinline__ int operator()(int n) const { return n; } };

__device__ __forceinline__ void p0_prologue(Frame& F) {
    if (F.vcu < 192) {
        const int ct = F.vcu % 24, kc = F.vcu / 24, kbase = kc * 256 + F.wave * 32;
        const float* Wp = F.w_ada + (size_t)kbase * 6144 + ct * 256 + F.lane * 4;
        f32x4 acc[8];
#pragma unroll
        for (int b = 0; b < 8; ++b) acc[b] = (f32x4){0.f, 0.f, 0.f, 0.f};
        for (int k = 0; k < 32; ++k) { const f32x4 wv = *(const f32x4*)(Wp + (size_t)k * 6144);
#pragma unroll
            for (int b = 0; b < 8; ++b) { const float cv = F.c[b * DM + kbase + k]; const float s = cv / (1.0f + __expf(-cv)); acc[b] = acc[b] + wv * s; } }
        LAS float* red = (LAS float*)F.lds;
#pragma unroll
        for (int b = 0; b < 8; ++b) *(LAS f32x4*)(red + F.wave * 2048 + b * 256 + F.lane * 4) = acc[b];
        __syncthreads();
        f32x4 s = (f32x4){0.f, 0.f, 0.f, 0.f};
#pragma unroll
        for (int w = 0; w < 8; ++w) s = s + *(const LAS f32x4*)(red + w * 2048 + F.tid * 4);
        const int b = F.tid >> 6, cc = (F.tid & 63) * 4;
        if (kc == 0) s = s + *(const f32x4*)(F.b_ada + ct * 256 + cc);
        *(f32x4*)(F.modp + ((size_t)(kc * 8 + b) * 6144 + ct * 256 + cc)) = s;
        __syncthreads();
    }
    LAS float* scr = (LAS float*)(F.lds + RING_OFF + F.wave * 16384);
    const int gw = F.vcu * NWAVES + F.wave, NGW = F.G * NWAVES;
    constexpr int I_IN = (DM / 64) * (NIN / 32), I_OUT = (DM / 64) * (DM / 32), I_UQ = (QLORA / 64) * (1536 / 32), I_UKV = (KVLORA / 64) * (2048 / 32);
    constexpr int NITEMS = I_IN + I_OUT + I_UQ + I_UKV;
    for (int it = gw; it < NITEMS; it += NGW) {
        int r = it;
        if (r < I_IN) { p0_transpose_item(F.w_in, DM, DIN, F.WinT, (const float*)nullptr, scr, r, NIN / 32, F.lane, MapIn()); continue; } r -= I_IN;
        if (r < I_OUT) { p0_transpose_item(F.w_out, DM, DM, F.WoutT, (const float*)nullptr, scr, r, DM / 32, F.lane, MapId()); continue; } r -= I_OUT;
        if (r < I_UQ) { p0_transpose_item(F.w_uq, QLORA, 1536, F.WuqT, F.g_q, scr, r, 1536 / 32, F.lane, MapUq()); continue; } r -= I_UQ;
        p0_transpose_item(F.w_ukv, KVLORA, 2048, F.WukvT, F.g_kv, scr, r, 2048 / 32, F.lane, MapUkv());
    }
    for (int i = gw * 64 + F.lane; i < T * 32; i += NGW * 64) { const int t = i >> 5, j = i & 31;
        const float inv = exp2f(-(float)j * (13.287712379549449f / 32.0f)); const float ang = (float)t * inv;
        const double rev = (double)ang * 0.15915494309189535; const float fr = (float)(rev - floor(rev));
        F.rope[i] = (f32x2){__builtin_amdgcn_cosf(fr), __builtin_amdgcn_sinf(fr)}; }
}

__device__ __forceinline__ float modsum(const float* modp, int b, int col) { float s = 0.f;
#pragma unroll
    for (int kc = 0; kc < 8; ++kc) s += modp[(size_t)(kc * 8 + b) * 6144 + col];
    return s; }
__device__ __forceinline__ void p1_modulate(Frame& F) {
    const int rows_per = M / F.G, r0 = F.vcu * rows_per, b = r0 / T;
    LAS float* gs = (LAS float*)F.lds; LAS float* sh = gs + DM;
    for (int k = F.tid; k < DM; k += NWAVES * 64) { gs[k] = F.g_pre[k] * (1.0f + modsum(F.modp, b, DM + k)); sh[k] = modsum(F.modp, b, k); }
    __syncthreads();
    for (int r = r0 + F.wave; r < r0 + rows_per; r += NWAVES) {
        const f32x4* xr = (const f32x4*)(F.x + (size_t)r * DM) + F.lane; f32x4 v[8]; float s = 0.f;
#pragma unroll
        for (int j = 0; j < 8; ++j) { v[j] = xr[64 * j]; s += (v[j].x * v[j].x + v[j].y * v[j].y) + (v[j].z * v[j].z + v[j].w * v[j].w); }
        const float rstd = 1.0f / sqrtf(wave_sum(s) * (1.0f / DM) + EPS);
        unsigned long long* o8 = (unsigned long long*)(F.H + (size_t)r * DM) + F.lane;
#pragma unroll
        for (int j = 0; j < 8; ++j) { const f32x4 g4 = *(const LAS f32x4*)(gs + 4 * (F.lane + 64 * j)), s4 = *(const LAS f32x4*)(sh + 4 * (F.lane + 64 * j));
            const f32x4 hv = v[j] * rstd * g4 + s4;
            o8[64 * j] = (unsigned long long)pk2(hv.x, hv.y) | ((unsigned long long)pk2(hv.z, hv.w) << 32); }
    }
    __syncthreads();
}

__device__ __forceinline__ float dot8(const bf16* kp, const LAS float* q) {
    const bf16x8 kv = *(const bf16x8*)kp; const f32x4 q0 = *(const LAS f32x4*)q, q1 = *(const LAS f32x4*)(q + 4);
    return (bf2f((bf16)kv[0]) * q0[0] + bf2f((bf16)kv[1]) * q0[1]) + (bf2f((bf16)kv[2]) * q0[2] + bf2f((bf16)kv[3]) * q0[3])
         + (bf2f((bf16)kv[4]) * q1[0] + bf2f((bf16)kv[5]) * q1[1]) + (bf2f((bf16)kv[6]) * q1[2] + bf2f((bf16)kv[7]) * q1[3]);
}
__device__ __forceinline__ void naive_dilated(Frame& F) {
    LAS float* pb = (LAS float*)(F.lds + F.wave * 16384); LAS float* qs = pb + 640;
    const int gw = F.vcu * NWAVES + F.wave, NGW = F.G * NWAVES;
    for (int task = gw; task < M * AH; task += NGW) {
        const int m = task >> 3, h = task & 7, b = m >> 11, t = m & (T - 1);
        const bf16* q = F.AQ + (size_t)m * 1024 + h * 128;
        qs[F.lane] = bf2f(q[F.lane]); qs[F.lane + 64] = bf2f(q[F.lane + 64]);
        LDS_WAIT(); asm volatile("" ::: "memory");
        const float slope2 = exp2f(-(float)(h + 1)) * LOG2E;
        float lse[3];
#pragma unroll
        for (int p = 0; p < 3; ++p) { const int dil = p == 0 ? 1 : (p == 1 ? 4 : 16);
            float sv[3];
#pragma unroll
            for (int c = 0; c < 3; ++c) { const int idx = F.lane + 64 * c, j = idx - 64, tk = t + j * dil; float s = -1e30f;
                if (idx < 129 && tk >= 0 && tk < T) { const bf16* kr = F.AK + (size_t)(b * T + tk) * 1024 + h * 128; float a = 0.f;
                    for (int d8 = 0; d8 < 16; ++d8) a += dot8(kr + d8 * 8, qs + d8 * 8);
                    s = a - slope2 * (float)(dil * (j < 0 ? -j : j)); }
                sv[c] = s; }
            const float mx = wave_max(fmaxf(fmaxf(sv[0], sv[1]), sv[2]));
            float e[3]; float l = 0.f;
#pragma unroll
            for (int c = 0; c < 3; ++c) { e[c] = exp2f(sv[c] - mx); l += e[c]; }
            l = wave_sum(l);
#pragma unroll
            for (int c = 0; c < 3; ++c) pb[p * 192 + F.lane + 64 * c] = e[c] / l;
            lse[p] = mx + log2f(l); }
        LDS_WAIT(); asm volatile("" ::: "memory");
        const float ml = fmaxf(fmaxf(lse[0], lse[1]), lse[2]);
        float w[3]; float wsum = 0.f;
#pragma unroll
        for (int p = 0; p < 3; ++p) { w[p] = exp2f(lse[p] - ml); wsum += w[p]; }
#pragma unroll
        for (int dd = 0; dd < 2; ++dd) { const int d = F.lane + 64 * dd; float o = 0.f;
#pragma unroll
            for (int p = 0; p < 3; ++p) { const int dil = p == 0 ? 1 : (p == 1 ? 4 : 16); float op = 0.f;
                for (int idx = 0; idx < 129; ++idx) { const int tk = t + (idx - 64) * dil;
                    if (tk >= 0 && tk < T) op += pb[p * 192 + idx] * bf2f(F.AV[(size_t)(b * T + tk) * 1024 + h * 128 + d]); }
                o += (w[p] / wsum) * op; }
            const float y = o * bf2f(F.AZ[(size_t)m * 1024 + h * 128 + d]);
            F.Y[(size_t)m * 2048 + h * 128 + d] = (bf16)f2bf(y); }
        LDS_WAIT(); asm volatile("" ::: "memory");
    }
}
__device__ __forceinline__ void naive_mla(Frame& F) {
    LAS float* pb = (LAS float*)(F.lds + F.wave * 16384); LAS float* qs = pb + 2048;
    const int gw = F.vcu * NWAVES + F.wave, NGW = F.G * NWAVES;
    for (int task = gw; task < M * BH; task += NGW) {
        const int m = task >> 3, h = task & 7, b = m >> 11;
        const bf16* q = F.Q + (size_t)m * 1536 + h * 192;
        qs[F.lane] = bf2f(q[F.lane]); qs[F.lane + 64] = bf2f(q[F.lane + 64]); qs[F.lane + 128] = bf2f(q[F.lane + 128]);
        LDS_WAIT(); asm volatile("" ::: "memory");
        float mx = -1e30f;
        for (int i = 0; i < 32; ++i) { const int tk = F.lane + 64 * i; const bf16* kr = F.KN + (size_t)(b * T + tk) * 1024 + h * 128; const bf16* pr = F.KPE + (size_t)(b * T + tk) * 64; float a = 0.f;
            for (int d8 = 0; d8 < 16; ++d8) a += dot8(kr + d8 * 8, qs + d8 * 8);
            for (int d8 = 0; d8 < 8; ++d8) a += dot8(pr + d8 * 8, qs + 128 + d8 * 8);
            pb[tk] = a; mx = fmaxf(mx, a); }
        mx = wave_max(mx); float l = 0.f;
        for (int i = 0; i < 32; ++i) { const int tk = F.lane + 64 * i; const float e = exp2f(pb[tk] - mx); pb[tk] = e; l += e; }
        l = wave_sum(l); const float inv = 1.0f / l;
        LDS_WAIT(); asm volatile("" ::: "memory");
#pragma unroll
        for (int dd = 0; dd < 2; ++dd) { const int d = F.lane + 64 * dd; float o = 0.f; const bf16* vp = F.V + (size_t)(b * T) * 1024 + h * 128 + d;
            for (int tk = 0; tk < T; ++tk) o += pb[tk] * bf2f(vp[(size_t)tk * 1024]);
            const float y = o * inv * bf2f(F.BZ[(size_t)m * 1024 + h * 128 + d]);
            F.Y[(size_t)m * 2048 + 1024 + h * 128 + d] = (bf16)f2bf(y); }
        LDS_WAIT(); asm volatile("" ::: "memory");
    }
}

__device__ __forceinline__ void p6_final(Frame& F) {
    const int rows_per = M / F.G, r0 = F.vcu * rows_per, b = r0 / T;
    LAS float* gg = (LAS float*)F.lds;
    for (int k = F.tid; k < DM; k += NWAVES * 64) gg[k] = F.g_post[k] * modsum(F.modp, b, 2 * DM + k);
    __syncthreads();
    for (int r = r0 + F.wave; r < r0 + rows_per; r += NWAVES) {
        float s = F.lane < 32 ? F.ssq_y[(size_t)r * 32 + F.lane] : 0.f;
        const float rstd = 1.0f / sqrtf(wave_sum(s) * (1.0f / DM) + EPS);
        const f32x4* xr = (const f32x4*)(F.x + (size_t)r * DM) + F.lane; const unsigned long long* y8 = (const unsigned long long*)(F.Y2 + (size_t)r * DM) + F.lane;
        f32x4* orow = (f32x4*)(F.out + (size_t)r * DM) + F.lane;
#pragma unroll
        for (int j = 0; j < 8; ++j) { const f32x4 xv = xr[64 * j]; const unsigned long long yv = y8[64 * j]; const f32x4 g4 = *(const LAS f32x4*)(gg + 4 * (F.lane + 64 * j));
            f32x4 y; y.x = __uint_as_float((unsigned)(yv & 0xffffu) << 16); y.y = __uint_as_float((unsigned)(yv & 0xffff0000u)); y.z = __uint_as_float((unsigned)((yv >> 32) & 0xffffu) << 16); y.w = __uint_as_float((unsigned)((yv >> 32) & 0xffff0000u));
            orow[64 * j] = xv + g4 * (y * rstd); }
    }
    __syncthreads();
}

namespace mla {
using bf16x8 = __attribute__((ext_vector_type(8))) short;
using s16x4  = __attribute__((ext_vector_type(4))) short;
using f32x16 = __attribute__((ext_vector_type(16))) float;
using u32x4  = __attribute__((ext_vector_type(4))) unsigned;
constexpr int QBLK = 32, KVBLK = 64;
constexpr int SHM_V = 16384, SHM_K = 16384, SHM_P = 8192;
constexpr int OFF_V = 0, OFF_K = 2 * SHM_V, OFF_P = OFF_K + 2 * SHM_K, OFF_WS = OFF_P + 2 * SHM_P, OFF_QP = OFF_WS + 8 * 64 * 4, LDS_TOTAL = OFF_QP + 8 * 4096;
#ifndef MLA_SDEPTH
#define MLA_SDEPTH 1
#endif
constexpr int SDEPTH = MLA_SDEPTH;
constexpr float THR2 = 11.5f;
#define MLA_KSWZ(row, colB) ((row) * 256 + ((colB) ^ (((row) & 7) << 4)))
#define MLA_PSWZ(row, colB) ((row) * 128 + ((colB) ^ ((((row) >> 1) & 7) << 4)))
#define MLA_SBAR() __builtin_amdgcn_sched_barrier(0)
typedef __attribute__((address_space(3))) char lchar;
__device__ __forceinline__ int crow(int r, int hi) { return (r & 3) + 8 * (r >> 2) + 4 * hi; }
__device__ __forceinline__ unsigned cvtpk(float lo, float hi) { unsigned r; asm volatile("v_cvt_pk_bf16_f32 %0, %1, %2" : "=v"(r) : "v"(lo), "v"(hi)); return r; }
__device__ __forceinline__ void partialSM(f32x16& p0, f32x16& p1, float& m_reg, float& alpha) {
  float pmax = p0[0];
#pragma unroll
  for (int r = 1; r < 16; ++r) pmax = fmaxf(pmax, p0[r]);
#pragma unroll
  for (int r = 0; r < 16; ++r) pmax = fmaxf(pmax, p1[r]);
  { auto rr = __builtin_amdgcn_permlane32_swap(__float_as_uint(pmax), __float_as_uint(pmax), false, false);
    pmax = fmaxf(__uint_as_float(rr[0]), __uint_as_float(rr[1])); }
  if (__builtin_expect(__all(pmax - m_reg <= THR2), 1)) { alpha = 1.f; }
  else { const float mn = fmaxf(m_reg, pmax); alpha = __builtin_amdgcn_exp2f(m_reg - mn); m_reg = mn; }
  const float mm = m_reg;
#pragma unroll
  for (int r = 0; r < 16; ++r) { p0[r] -= mm; p1[r] -= mm; }
#pragma unroll
  for (int r = 0; r < 16; ++r) p0[r] = __builtin_amdgcn_exp2f(p0[r]);
}
__device__ __forceinline__ void finishSM(f32x16& p0, f32x16& p1, float alpha, float& l_reg, bf16x8& pa0, bf16x8& pa1, bf16x8& pa2, bf16x8& pa3) {
#pragma unroll
  for (int r = 0; r < 16; ++r) p1[r] = __builtin_amdgcn_exp2f(p1[r]);
  float ps = 0;
#pragma unroll
  for (int r = 0; r < 16; ++r) ps += p0[r];
#pragma unroll
  for (int r = 0; r < 16; ++r) ps += p1[r];
  { auto rr = __builtin_amdgcn_permlane32_swap(__float_as_uint(ps), __float_as_uint(ps), false, false);
    ps = __uint_as_float(rr[0]) + __uint_as_float(rr[1]); }
  l_reg = l_reg * alpha + ps;
#define MLA_PK4(P, BASE, OUT) do { unsigned a0 = cvtpk(P[BASE + 0], P[BASE + 1]), a1 = cvtpk(P[BASE + 2], P[BASE + 3]);   \
    unsigned b0 = cvtpk(P[BASE + 4], P[BASE + 5]), b1 = cvtpk(P[BASE + 6], P[BASE + 7]);                              \
    auto r0 = __builtin_amdgcn_permlane32_swap(a0, b0, false, false); auto r1 = __builtin_amdgcn_permlane32_swap(a1, b1, false, false); \
    u32x4 w = {r0[0], r1[0], r0[1], r1[1]}; OUT = __builtin_bit_cast(bf16x8, w); } while (0)
  MLA_PK4(p0, 0, pa0); MLA_PK4(p0, 8, pa1); MLA_PK4(p1, 0, pa2); MLA_PK4(p1, 8, pa3);
#undef MLA_PK4
}
__device__ __forceinline__ void qkt(f32x16& p0, f32x16& p1, const lchar* Ks, const lchar* Ps, const bf16x8* qr, const lchar* Qp, int r32, int hi) {
  p0 = f32x16{}; p1 = f32x16{};
#pragma unroll
  for (int d0 = 0; d0 < 8; ++d0) { const int cb = (d0 * 16 + hi * 8) * 2;
    const bf16x8 b0 = *(const __attribute__((address_space(3))) bf16x8*)(Ks + MLA_KSWZ(r32, cb));
    const bf16x8 b1 = *(const __attribute__((address_space(3))) bf16x8*)(Ks + MLA_KSWZ(32 + r32, cb));
    p0 = __builtin_amdgcn_mfma_f32_32x32x16_bf16(b0, qr[d0], p0, 0, 0, 0);
    p1 = __builtin_amdgcn_mfma_f32_32x32x16_bf16(b1, qr[d0], p1, 0, 0, 0); }
#pragma unroll
  for (int d0 = 0; d0 < 4; ++d0) { const int cb = (d0 * 16 + hi * 8) * 2;
    const bf16x8 b0 = *(const __attribute__((address_space(3))) bf16x8*)(Ps + MLA_PSWZ(r32, cb));
    const bf16x8 b1 = *(const __attribute__((address_space(3))) bf16x8*)(Ps + MLA_PSWZ(32 + r32, cb));
    const bf16x8 qp = *(const __attribute__((address_space(3))) bf16x8*)(Qp + MLA_PSWZ(r32, cb));
    p0 = __builtin_amdgcn_mfma_f32_32x32x16_bf16(b0, qp, p0, 0, 0, 0);
    p1 = __builtin_amdgcn_mfma_f32_32x32x16_bf16(b1, qp, p1, 0, 0, 0); }
}
__device__ __forceinline__ int v_st(int k, int c) { const int kk = (k & ~0xC) | ((k & 4) << 1) | ((k & 8) >> 1); return ((kk >> 3) * 4 + (c >> 5)) * 512 + ((kk & 7) * 32 + (c & 31)) * 2; }
__device__ __forceinline__ int v_rd_base(int lane) { return ((lane & 3) << 3) | (((lane >> 2) & 3) << 6) | (((lane >> 4) & 1) << 5) | (((lane >> 5) & 1) << 8); }
constexpr int v_rd_off(int d0, int ks, int half) { return d0 * 512 + ks * 4096 + half * 2048; }
template <int OFF> __device__ __forceinline__ s16x4 tr_read(int vb) { s16x4 r; asm volatile("ds_read_b64_tr_b16 %0, %1 offset:%2" : "=&v"(r) : "v"(vb), "i"(OFF) : "memory"); return r; }
template <int D0> __device__ __forceinline__ void pv_one(f32x16& od, int vb, bf16x8 pa0, bf16x8 pa1, bf16x8 pa2, bf16x8 pa3) {
  const s16x4 l0 = tr_read<v_rd_off(D0, 0, 0)>(vb), h0 = tr_read<v_rd_off(D0, 0, 1)>(vb), l1 = tr_read<v_rd_off(D0, 1, 0)>(vb), h1 = tr_read<v_rd_off(D0, 1, 1)>(vb);
  const s16x4 l2 = tr_read<v_rd_off(D0, 2, 0)>(vb), h2 = tr_read<v_rd_off(D0, 2, 1)>(vb), l3 = tr_read<v_rd_off(D0, 3, 0)>(vb), h3 = tr_read<v_rd_off(D0, 3, 1)>(vb);
  asm volatile("s_waitcnt lgkmcnt(0)" ::: "memory"); MLA_SBAR();
#define MLA_PK(L, H) (bf16x8){L[0], L[1], L[2], L[3], H[0], H[1], H[2], H[3]}
  od = __builtin_amdgcn_mfma_f32_32x32x16_bf16(pa0, MLA_PK(l0, h0), od, 0, 0, 0);
  od = __builtin_amdgcn_mfma_f32_32x32x16_bf16(pa1, MLA_PK(l1, h1), od, 0, 0, 0);
  od = __builtin_amdgcn_mfma_f32_32x32x16_bf16(pa2, MLA_PK(l2, h2), od, 0, 0, 0);
  od = __builtin_amdgcn_mfma_f32_32x32x16_bf16(pa3, MLA_PK(l3, h3), od, 0, 0, 0);
#undef MLA_PK
}
__device__ __forceinline__ void pv_d0(f32x16* o, int vb, bf16x8 pa0, bf16x8 pa1, bf16x8 pa2, bf16x8 pa3) {
  pv_one<0>(o[0], vb, pa0, pa1, pa2, pa3); pv_one<1>(o[1], vb, pa0, pa1, pa2, pa3); pv_one<2>(o[2], vb, pa0, pa1, pa2, pa3); pv_one<3>(o[3], vb, pa0, pa1, pa2, pa3);
}
__device__ __forceinline__ void unit(const bf16* __restrict__ Qb, const bf16* __restrict__ Kh, const bf16* __restrict__ Vh, const bf16* __restrict__ Ph,
                                     const bf16* __restrict__ Zb, bf16* __restrict__ Yb, lchar* lds) {
  constexpr int LDQ = 1536, LDK = 1024, LDP = 64, seq = 2048;
  int tid_ = threadIdx.x; asm volatile("" : "+v"(tid_));
  const int tid = tid_, wid = __builtin_amdgcn_readfirstlane(tid >> 6), lane = tid & 63, r32 = lane & 31, hi = lane >> 5;
  lchar* V_lds = lds + OFF_V; lchar* K_lds = lds + OFF_K; lchar* P_lds = lds + OFF_P;
  __attribute__((address_space(3))) float* ws = (__attribute__((address_space(3))) float*)(lds + OFF_WS) + wid * 64; __attribute__((address_space(3))) float* li_l = ws; __attribute__((address_space(3))) float* al_l = ws + 32;
  float m_reg = -1e30f, l_reg = 0; f32x16 o[4] = {}; bf16x8 qr[8]; lchar* Qp = lds + OFF_QP + wid * 4096;
  const bf16* Qw = Qb + (long)(wid * QBLK + r32) * LDQ + hi * 8;
#pragma unroll
  for (int d0 = 0; d0 < 8; ++d0) qr[d0] = *(const bf16x8*)(Qw + d0 * 16);
#pragma unroll
  for (int d0 = 0; d0 < 4; ++d0) *(__attribute__((address_space(3))) bf16x8*)(Qp + MLA_PSWZ(r32, (d0 * 16 + hi * 8) * 2)) = *(const bf16x8*)(Qw + 128 + d0 * 16);
  const int sr = tid >> 4, sc = (tid & 15) * 8, vst0 = v_st(sr, sc), vst1 = v_st(32 + sr, sc), pr = tid >> 3, pc = (tid & 7) * 8;
  const int vb0 = (int)(uintptr_t)V_lds + v_rd_base(lane);
  struct { bf16x8 vs0, vs1, ks0, ks1, ps; } sr_[SDEPTH];
#define SLOAD(i, k0) do { sr_[i].vs0 = *(const bf16x8*)(&Vh[(long)((k0) + sr) * LDK + sc]); sr_[i].vs1 = *(const bf16x8*)(&Vh[(long)((k0) + 32 + sr) * LDK + sc]); \
    sr_[i].ks0 = *(const bf16x8*)(&Kh[(long)((k0) + sr) * LDK + sc]); sr_[i].ks1 = *(const bf16x8*)(&Kh[(long)((k0) + 32 + sr) * LDK + sc]); \
    sr_[i].ps = *(const bf16x8*)(&Ph[(long)((k0) + pr) * LDP + pc]); } while (0)
#define SWRITE(b, i) do { *(__attribute__((address_space(3))) bf16x8*)(V_lds + (b) * SHM_V + vst0) = sr_[i].vs0;          \
    *(__attribute__((address_space(3))) bf16x8*)(V_lds + (b) * SHM_V + vst1) = sr_[i].vs1; const int kc = sc * 2;               \
    *(__attribute__((address_space(3))) bf16x8*)(K_lds + (b) * SHM_K + MLA_KSWZ(sr, kc)) = sr_[i].ks0;                       \
    *(__attribute__((address_space(3))) bf16x8*)(K_lds + (b) * SHM_K + MLA_KSWZ(32 + sr, kc)) = sr_[i].ks1;                  \
    *(__attribute__((address_space(3))) bf16x8*)(P_lds + (b) * SHM_P + MLA_PSWZ(pr, pc * 2)) = sr_[i].ps; } while (0)
#define SWAIT() do { if constexpr (SDEPTH == 2) asm volatile("s_waitcnt vmcnt(5)" ::: "memory"); else asm volatile("s_waitcnt vmcnt(0)" ::: "memory"); } while (0)
#define RESC(a) do { if (__any((a) < 1.f)) { if (hi == 0) al_l[r32] = (a); asm volatile("s_waitcnt lgkmcnt(0)" ::: "memory"); \
    _Pragma("unroll") for (int d = 0; d < 4; ++d) _Pragma("unroll") for (int r = 0; r < 16; ++r) o[d][r] *= al_l[crow(r, hi)]; } } while (0)
  f32x16 pA0, pA1, pB0, pB1; float alA, alB; bf16x8 pa0, pa1, pa2, pa3; constexpr int NT = seq / KVBLK;
  constexpr int SE = 0, SO = SDEPTH - 1;
  SLOAD(SE, 0); asm volatile("s_waitcnt vmcnt(0)" ::: "memory"); SWRITE(0, SE); __syncthreads();
  qkt(pA0, pA1, K_lds, P_lds, qr, Qp, r32, hi); partialSM(pA0, pA1, m_reg, alA);
  SLOAD(SO, KVBLK); if constexpr (SDEPTH == 2) { if (2 < NT) SLOAD(SE, 2 * KVBLK); }
  SWAIT(); SWRITE(1, SO); __syncthreads();
  for (int j = 1; j + 1 < NT; j += 2) {
    MLA_SBAR(); qkt(pB0, pB1, K_lds + SHM_K, P_lds + SHM_P, qr, Qp, r32, hi);
    finishSM(pA0, pA1, alA, l_reg, pa0, pa1, pa2, pa3); MLA_SBAR();
    SLOAD(SO, (j + SDEPTH) * KVBLK); MLA_SBAR();
    pv_d0(o, vb0, pa0, pa1, pa2, pa3); partialSM(pB0, pB1, m_reg, alB);
    __syncthreads(); SWAIT(); SWRITE(0, SE);
    RESC(alB); __syncthreads();
    MLA_SBAR(); qkt(pA0, pA1, K_lds, P_lds, qr, Qp, r32, hi);
    finishSM(pB0, pB1, alB, l_reg, pa0, pa1, pa2, pa3); MLA_SBAR();
    if (SDEPTH == 1 || j + 3 < NT) SLOAD(SE, (j + 1 + SDEPTH) * KVBLK); MLA_SBAR();
    pv_d0(o, vb0 + SHM_V, pa0, pa1, pa2, pa3); partialSM(pA0, pA1, m_reg, alA);
    __syncthreads(); SWAIT(); SWRITE(1, SO);
    RESC(alA); __syncthreads();
  }
  MLA_SBAR(); qkt(pB0, pB1, K_lds + SHM_K, P_lds + SHM_P, qr, Qp, r32, hi);
  finishSM(pA0, pA1, alA, l_reg, pa0, pa1, pa2, pa3); MLA_SBAR();
  pv_d0(o, vb0, pa0, pa1, pa2, pa3); partialSM(pB0, pB1, m_reg, alB);
  __syncthreads(); RESC(alB);
  finishSM(pB0, pB1, alB, l_reg, pa0, pa1, pa2, pa3); MLA_SBAR();
  pv_d0(o, vb0 + SHM_V, pa0, pa1, pa2, pa3);
  if (hi == 0) li_l[r32] = l_reg; asm volatile("s_waitcnt lgkmcnt(0)" ::: "memory");
  float rli[16];
#pragma unroll
  for (int r = 0; r < 16; ++r) rli[r] = __builtin_amdgcn_rcpf(li_l[crow(r, hi)]);
  const bf16* Zw = Zb + (long)(wid * QBLK) * 1024; bf16* Yw = Yb + (long)(wid * QBLK) * 2048;
#pragma unroll
  for (int r = 0; r < 16; ++r) { const int orow = crow(r, hi);
#pragma unroll
    for (int d0 = 0; d0 < 4; ++d0) { const float z = bf2f(Zw[(long)orow * 1024 + d0 * 32 + r32]); Yw[(long)orow * 2048 + d0 * 32 + r32] = (bf16)f2bf(o[d0][r] * rli[r] * z); }
    if (r & 1) asm volatile("" ::: "memory"); }
  __syncthreads();
#undef SLOAD
#undef SWRITE
#undef SWAIT
#undef RESC
}
}
__device__ __forceinline__ void mla_phase(Frame& F) {
#pragma nounroll
  for (int i = 0; i < 2; ++i) { const int bh = F.vcu >> 2, qb = (F.vcu & 3) + 4 * i, b = bh >> 3, h = bh & 7; const long row0 = (long)b * T + qb * 256;
    mla::unit(F.Q + row0 * 1536 + h * 192, F.KN + (long)b * T * 1024 + h * 128, F.V + (long)b * T * 1024 + h * 128, F.KPE + (long)b * T * 64,
              F.BZ + row0 * 1024 + h * 128, F.Y + row0 * 2048 + 1024 + h * 128, (mla::lchar*)(F.lds + RING_OFF)); }
}
namespace dil {
using mla::bf16x8; using mla::s16x4; using mla::f32x16; using mla::u32x4; using mla::lchar; using mla::crow; using mla::cvtpk; using mla::v_st; using mla::v_rd_base; using mla::tr_read; using mla::v_rd_off;
#define DIL_PK4(P, BASE, OUT) do { unsigned a0 = cvtpk(P[BASE + 0], P[BASE + 1]), a1 = cvtpk(P[BASE + 2], P[BASE + 3]);   \
    unsigned b0 = cvtpk(P[BASE + 4], P[BASE + 5]), b1 = cvtpk(P[BASE + 6], P[BASE + 7]);                              \
    auto r0 = __builtin_amdgcn_permlane32_swap(a0, b0, false, false); auto r1 = __builtin_amdgcn_permlane32_swap(a1, b1, false, false); \
    u32x4 w = {r0[0], r1[0], r0[1], r1[1]}; OUT = __builtin_bit_cast(bf16x8, w); } while (0)
template <int D0> __device__ __forceinline__ void pv32(f32x16& od, int vb, bf16x8 pa0, bf16x8 pa1) {
  const s16x4 l0 = tr_read<v_rd_off(D0, 0, 0)>(vb), h0 = tr_read<v_rd_off(D0, 0, 1)>(vb), l1 = tr_read<v_rd_off(D0, 1, 0)>(vb), h1 = tr_read<v_rd_off(D0, 1, 1)>(vb);
  asm volatile("s_waitcnt lgkmcnt(0)" ::: "memory"); __builtin_amdgcn_sched_barrier(0);
#define DIL_PK(L, H) (bf16x8){L[0], L[1], L[2], L[3], H[0], H[1], H[2], H[3]}
  od = __builtin_amdgcn_mfma_f32_32x32x16_bf16(pa0, DIL_PK(l0, h0), od, 0, 0, 0);
  od = __builtin_amdgcn_mfma_f32_32x32x16_bf16(pa1, DIL_PK(l1, h1), od, 0, 0, 0);
#undef DIL_PK
}
template <int DIL>
__device__ __forceinline__ void wave_unit(int b, int h, int res, int u0, const bf16* __restrict__ AQ, const bf16* __restrict__ AK, const bf16* __restrict__ AV,
                                          bf16* __restrict__ OP, float* __restrict__ LSE, lchar* vl, __attribute__((address_space(3))) float* sc, int lane) {
  constexpr int L = T / DIL;
  const int r32 = lane & 31, hi = lane >> 5;
  const long rowb = (long)b * T;
  bf16x8 qr[8];
  { const bf16* Qw = AQ + (rowb + (long)(u0 + r32) * DIL + res) * 1024 + h * 128 + hi * 8;
#pragma unroll
    for (int d0 = 0; d0 < 8; ++d0) qr[d0] = *(const bf16x8*)(Qw + d0 * 16); }
  f32x16 p[5];
#pragma unroll
  for (int kb = 0; kb < 5; ++kb) { int ku = u0 - 64 + 32 * kb + r32; ku = ku < 0 ? 0 : (ku > L - 1 ? L - 1 : ku);
    const bf16* Kw = AK + (rowb + (long)ku * DIL + res) * 1024 + h * 128 + hi * 8;
    p[kb] = f32x16{};
#pragma unroll
    for (int d0 = 0; d0 < 8; ++d0) { const bf16x8 a = *(const bf16x8*)(Kw + d0 * 16); p[kb] = __builtin_amdgcn_mfma_f32_32x32x16_bf16(a, qr[d0], p[kb], 0, 0, 0); } }
  const float slope = exp2f(-(float)(h + 1)) * (LOG2E * (float)DIL);
  float mx = -1e30f;
#pragma unroll
  for (int kb = 0; kb < 5; ++kb)
#pragma unroll
    for (int r = 0; r < 16; ++r) { const int kr = crow(r, hi), j = -64 + 32 * kb + kr - r32, ku = u0 - 64 + 32 * kb + kr; const int aj = j < 0 ? -j : j;
      const bool valid = (aj <= 64) && (ku >= 0) && (ku < L);
      const float s = valid ? p[kb][r] - slope * (float)aj : -1e30f; p[kb][r] = s; mx = fmaxf(mx, s); }
  { auto rr = __builtin_amdgcn_permlane32_swap(__float_as_uint(mx), __float_as_uint(mx), false, false); mx = fmaxf(__uint_as_float(rr[0]), __uint_as_float(rr[1])); }
  float l = 0.f;
#pragma unroll
  for (int kb = 0; kb < 5; ++kb)
#pragma unroll
    for (int r = 0; r < 16; ++r) { const float e = __builtin_amdgcn_exp2f(p[kb][r] - mx); p[kb][r] = e; l += e; }
  { auto rr = __builtin_amdgcn_permlane32_swap(__float_as_uint(l), __float_as_uint(l), false, false); l = __uint_as_float(rr[0]) + __uint_as_float(rr[1]); }
  f32x16 o[4] = {};
  const int vk = lane >> 4, vc = (lane & 15) * 8; const int vb0 = (int)(uintptr_t)vl + v_rd_base(lane);
  bf16x8 vs[8];
#define DIL_VLOAD(kb) do { _Pragma("unroll") for (int i = 0; i < 8; ++i) { int ku = u0 - 64 + 32 * (kb) + 4 * i + vk; ku = ku < 0 ? 0 : (ku > L - 1 ? L - 1 : ku); \
    vs[i] = *(const bf16x8*)(AV + (rowb + (long)ku * DIL + res) * 1024 + h * 128 + vc); } } while (0)
#define DIL_VWRITE(buf) do { _Pragma("unroll") for (int i = 0; i < 8; ++i) *(__attribute__((address_space(3))) bf16x8*)(vl + (buf) * 8192 + v_st(4 * i + vk, vc)) = vs[i]; } while (0)
  DIL_VLOAD(0);
#pragma unroll
  for (int kb = 0; kb < 5; ++kb) { const int buf = kb & 1;
    DIL_VWRITE(buf);
    if (kb + 1 < 5) DIL_VLOAD(kb + 1);
    bf16x8 pa0, pa1; DIL_PK4(p[kb], 0, pa0); DIL_PK4(p[kb], 8, pa1);
    asm volatile("s_waitcnt lgkmcnt(0)" ::: "memory"); __builtin_amdgcn_sched_barrier(0);
    pv32<0>(o[0], vb0 + buf * 8192, pa0, pa1); pv32<1>(o[1], vb0 + buf * 8192, pa0, pa1); pv32<2>(o[2], vb0 + buf * 8192, pa0, pa1); pv32<3>(o[3], vb0 + buf * 8192, pa0, pa1); }
#undef DIL_VLOAD
#undef DIL_VWRITE
  if (hi == 0) { sc[r32] = l; LSE[(rowb + (long)(u0 + r32) * DIL + res) * 8 + h] = mx + log2f(l); }
  asm volatile("s_waitcnt lgkmcnt(0)" ::: "memory");
#pragma unroll
  for (int r = 0; r < 16; ++r) { const int orow = crow(r, hi); const float rl = __builtin_amdgcn_rcpf(sc[orow]);
    bf16* Ow = OP + (rowb + (long)(u0 + orow) * DIL + res) * 1024 + h * 128 + r32;
#pragma unroll
    for (int d0 = 0; d0 < 4; ++d0) Ow[d0 * 32] = (bf16)f2bf(o[d0][r] * rl);
    if ((r & 3) == 3) asm volatile("" ::: "memory"); }
  asm volatile("s_waitcnt lgkmcnt(0)" ::: "memory");
}
#undef DIL_PK4
}
__device__ __forceinline__ void dilated_phase(Frame& F) {
  mla::lchar* vl = (mla::lchar*)(F.lds + RING_OFF) + F.wave * 16384; LAS float* sc = (LAS float*)(F.lds + LDSCTL_OFF + 1024) + F.wave * 64;
  const int b = F.vcu >> 5, w = (F.vcu & 31) * NWAVES + F.wave;
#pragma nounroll
  for (int id = w; id < 8 * 192; id += 256) { int lane_ = F.lane; asm volatile("" : "+v"(lane_));
    const int h = id / 192, rem = id % 192, p = rem >> 6, i = rem & 63;
    const size_t opoff = p == 0 ? WS_OP0 : (p == 1 ? WS_OP1 : WS_OP2); bf16* OP = (bf16*)(F.wsb + opoff); float* LSE = F.LSEP + (size_t)p * ((size_t)M * 8);
    if (p == 0) dil::wave_unit<1>(b, h, 0, i * 32, F.AQ, F.AK, F.AV, OP, LSE, vl, sc, lane_);
    else if (p == 1) dil::wave_unit<4>(b, h, i >> 4, (i & 15) * 32, F.AQ, F.AK, F.AV, OP, LSE, vl, sc, lane_);
    else dil::wave_unit<16>(b, h, i >> 2, (i & 3) * 32, F.AQ, F.AK, F.AV, OP, LSE, vl, sc, lane_); }
}
__device__ __forceinline__ void dilated_merge(Frame& F) {
  const int gw = F.vcu * NWAVES + F.wave, NGW = F.G * NWAVES;
  for (int m = gw; m < M; m += NGW) { const int h = F.lane >> 3;
    const float l0 = F.LSEP[(size_t)m * 8 + h], l1 = F.LSEP[(size_t)M * 8 + (size_t)m * 8 + h], l2 = F.LSEP[(size_t)M * 16 + (size_t)m * 8 + h];
    const float ml = fmaxf(fmaxf(l0, l1), l2); float w0 = exp2f(l0 - ml), w1 = exp2f(l1 - ml), w2 = exp2f(l2 - ml); const float inv = 1.0f / (w0 + w1 + w2); w0 *= inv; w1 *= inv; w2 *= inv;
#pragma unroll
    for (int c = 0; c < 2; ++c) { const size_t off = (size_t)m * 1024 + F.lane * 16 + c * 8;
      const bf16x8 a0 = *(const bf16x8*)(F.OP0 + off), a1 = *(const bf16x8*)(F.OP1 + off), a2 = *(const bf16x8*)(F.OP2 + off), z = *(const bf16x8*)(F.AZ + off);
      v4u o;
#define MIX(e) ((w0 * bf2f((bf16)a0[e]) + w1 * bf2f((bf16)a1[e]) + w2 * bf2f((bf16)a2[e])) * bf2f((bf16)z[e]))
      o.x = pk2(MIX(0), MIX(1)); o.y = pk2(MIX(2), MIX(3)); o.z = pk2(MIX(4), MIX(5)); o.w = pk2(MIX(6), MIX(7));
#undef MIX
      *(v4u*)(F.Y + (size_t)m * 2048 + F.lane * 16 + c * 8) = o; } }
}
struct Args { const float* in[12]; float* out; unsigned char* ws; int ph_lo, ph_hi; };
__global__ void __launch_bounds__(NWAVES * 64, 2) mega_fwd(Args args) {
    extern __shared__ __attribute__((aligned(16))) unsigned char lds[];
    Frame F;
    F.lds = (LAS unsigned char*)lds; F.MISC = (volatile LAS unsigned*)(F.lds + MISC_OFF);
    F.tid = threadIdx.x; F.lane = F.tid & 63; F.wave = __builtin_amdgcn_readfirstlane(F.tid >> 6);
    F.G = gridDim.x; { const int bx = blockIdx.x; F.vcu = (F.G % 8 == 0) ? (bx % 8) * (F.G / 8) + bx / 8 : bx; }
    unsigned char* ws = args.ws;
    F.ctl = (unsigned*)(ws + WS_CTL);
    F.x = args.in[0]; F.c = args.in[1]; F.w_ada = args.in[2]; F.b_ada = args.in[3]; F.g_pre = args.in[4]; F.w_in = args.in[5]; F.g_q = args.in[6]; F.w_uq = args.in[7];
    F.g_kv = args.in[8]; F.w_ukv = args.in[9]; F.w_out = args.in[10]; F.g_post = args.in[11]; F.out = args.out;
    F.WinT = (bf16*)(ws + WS_WIN); F.WoutT = (bf16*)(ws + WS_WOUT); F.WuqT = (bf16*)(ws + WS_WUQ); F.WukvT = (bf16*)(ws + WS_WUKV);
    F.H = (bf16*)(ws + WS_H); F.Y = (bf16*)(ws + WS_Y); F.AQ = (bf16*)(ws + WS_AQ); F.AK = (bf16*)(ws + WS_AK); F.AV = (bf16*)(ws + WS_AV); F.AZ = (bf16*)(ws + WS_AZ); F.BZ = (bf16*)(ws + WS_BZ);
    F.CQ = (bf16*)(ws + WS_CQ); F.CKV = (bf16*)(ws + WS_CKV); F.KPE = (bf16*)(ws + WS_KPE); F.Q = (bf16*)(ws + WS_Q); F.KN = (bf16*)(ws + WS_KN); F.V = (bf16*)(ws + WS_V); F.Y2 = (bf16*)(ws + WS_Y2);
    F.modp = (float*)(ws + WS_MODP); F.ssq_q = (float*)(ws + WS_SSQQ); F.ssq_kv = (float*)(ws + WS_SSQKV); F.ssq_y = (float*)(ws + WS_SSQY); F.rope = (f32x2*)(ws + WS_ROPE);
    F.wsb = ws; F.OP0 = (bf16*)(ws + WS_OP0); F.OP1 = (bf16*)(ws + WS_OP1); F.OP2 = (bf16*)(ws + WS_OP2); F.LSEP = (float*)(ws + WS_LSEP);
    for (int u = F.tid; u < (LDS_BYTES - LDSCTL_OFF) / 4; u += NWAVES * 64) ((LAS unsigned*)(F.lds + LDSCTL_OFF))[u] = 0u;
    __syncthreads();
    XcdBarrier bar; bar.bar = F.ctl + CW_BAR; bar.x = 0; bar.st = nullptr;
    if (N_LAUNCHES == 1) bar = xcd_barrier_post(F.ctl + CW_BAR, F.MISC + 8);
    const int lo = args.ph_lo, hi = args.ph_hi;
#define IN(k) (lo <= (k) && (k) < hi)
#define SEAM(k) do { if (IN(k) && IN((k) + 1)) xcd_barrier(bar); } while (0)

    if (IN(0)) { p0_prologue(F); } SEAM(0);
    if (IN(1)) { p1_modulate(F); } SEAM(1);
    if (IN(2)) {
        pg8::Gemm g{F.H, F.WinT, M, NIN, DM}; pg8::StaticOrder S; S.init(M, NIN, F.G, (int)blockIdx.x);
        pg8::EpiProj E{F.AQ, F.AK, F.AV, F.AZ, F.BZ, F.CQ, F.CKV, F.KPE, F.ssq_q, F.ssq_kv, F.rope};
        pg8::gemm_phase<pg8::EpiProj, pg8::StaticOrder, true, true>(F.lds + RING_OFF, g, S, E);
    } SEAM(2);
    if (IN(3)) {
        { pg8::Gemm g{F.CQ, F.WuqT, M, 1536, QLORA}; pg8::StaticOrder S; S.init(M, 1536, F.G, (int)blockIdx.x);
          pg8::EpiUpQ E{F.Q, F.ssq_q, F.rope};
          pg8::gemm_phase<pg8::EpiUpQ, pg8::StaticOrder, true, true>(F.lds + RING_OFF, g, S, E); }
        { pg8::Gemm g{F.CKV, F.WukvT, M, 2048, KVLORA}; pg8::StaticOrder S; S.init(M, 2048, F.G, (int)blockIdx.x);
          pg8::EpiUpKV E{F.KN, F.V, F.ssq_kv};
          pg8::gemm_phase<pg8::EpiUpKV, pg8::StaticOrder, true, true>(F.lds + RING_OFF, g, S, E); }
#if defined(NAIVE_DIL)
        naive_dilated(F);
#else
        dilated_phase(F);
#endif
    } SEAM(3);
    if (IN(4)) {
#if !defined(NAIVE_DIL)
        dilated_merge(F);
#endif
#if defined(NAIVE_MLA)
        naive_mla(F);
#else
        mla_phase(F);
#endif
    } SEAM(4);
    if (IN(5)) {
        pg8::Gemm g{F.Y, F.WoutT, M, DM, DM}; pg8::StaticOrder S; S.init(M, DM, F.G, (int)blockIdx.x);
        pg8::EpiOut E{F.Y2, F.ssq_y};
        pg8::gemm_phase<pg8::EpiOut, pg8::StaticOrder, true, true>(F.lds + RING_OFF, g, S, E);
    } SEAM(5);
    if (IN(6)) { p6_final(F); }
#undef IN
#undef SEAM
}

extern "C" void kernel_launch(void* const* d_in, const int* in_sizes, int n_in, void* d_out, int out_size, void* d_ws, size_t ws_size, hipStream_t stream) {
    static int grid = 0;
    if (grid == 0) {
        if (n_in != 12 || in_sizes[0] != M * DM || out_size != M * DM || ws_size < WS_END) { fprintf(stderr, "kernel_launch: unexpected shapes (n_in %d, in0 %d, out %d, ws %zu); nothing launched\n", n_in, n_in > 0 ? in_sizes[0] : -1, out_size, ws_size); grid = -1; return; }
        int dev = 0, cus = 0, per_cu = 0;
        if (hipGetDevice(&dev) != hipSuccess || hipDeviceGetAttribute(&cus, hipDeviceAttributeMultiprocessorCount, dev) != hipSuccess) { grid = -1; return; }
        if (hipFuncSetAttribute((const void*)mega_fwd, hipFuncAttributeMaxDynamicSharedMemorySize, LDS_BYTES) != hipSuccess) { fprintf(stderr, "kernel_launch: hipFuncSetAttribute failed\n"); grid = -1; return; }
        if (hipOccupancyMaxActiveBlocksPerMultiprocessor(&per_cu, (const void*)mega_fwd, NWAVES * 64, LDS_BYTES) != hipSuccess) per_cu = 0;
        (void)hipGetLastError();
        if (per_cu < 1 || cus * per_cu < 256) { fprintf(stderr, "kernel_launch: needs 256 co-resident workgroups, the device admits %d x %d; nothing launched\n", cus, per_cu); grid = -1; return; }
        grid = 256;
    }
    if (grid < 0) return;
    if (hipMemsetAsync((char*)d_ws + WS_CTL, 0, CTL_ZERO_BYTES, stream) != hipSuccess) return;
    Args a{};
    for (int i = 0; i < 12; ++i) a.in[i] = (const float*)d_in[i];
    a.out = (float*)d_out; a.ws = (unsigned char*)d_ws;
    if (N_LAUNCHES == 1) { a.ph_lo = 0; a.ph_hi = N_PHASES; hipLaunchKernelGGL(mega_fwd, dim3(grid), dim3(NWAVES * 64), LDS_BYTES, stream, a); }
    else for (int p = 0; p < N_PHASES; ++p) { a.ph_lo = p; a.ph_hi = p + 1; hipLaunchKernelGGL(mega_fwd, dim3(grid), dim3(NWAVES * 64), LDS_BYTES, stream, a); }
}
```
